# Optimizing an MI355X kernel written in HIP

```python
import jax, jax.numpy as jnp
from jax import lax
import numpy as np

D_MODEL = 2048
BATCH = 2
SEQ = 4096
DEPTH = 1

N_META = 16
BLK = 128
WINDOW = 128
HEAD_DIM = 64
N_Q_HEADS = D_MODEL // 128
N_KV_HEADS = N_Q_HEADS // 4
Q_PER_KV = N_Q_HEADS // N_KV_HEADS
ATTN_DIM = N_Q_HEADS * HEAD_DIM
KV_DIM = N_KV_HEADS * HEAD_DIM
ROT_DIM = HEAD_DIM // 4
ROPE_THETA = 500000.0
CONV_DIM = D_MODEL // 2
CONV_K = 3
N_EXPERTS = 32
TOP_K = 4
D_FF = D_MODEL
SWIGLU_ALPHA = 1.702
SWIGLU_LIMIT = 7.0
MOE_BLK = 128
RMS_EPS = 1e-5
IN_SIZES = (ATTN_DIM, KV_DIM, KV_DIM, CONV_DIM, CONV_DIM, CONV_DIM, D_MODEL, D_MODEL)
IN_DIM = ATTN_DIM + 2 * KV_DIM + 3 * CONV_DIM + 2 * D_MODEL

kernel_name = "hybrid_gated_conv_swa_moe_encoder"


def rmsnorm(x, g):
    xf = x.astype(jnp.float32)
    y = xf * lax.rsqrt(jnp.mean(xf * xf, axis=-1, keepdims=True) + RMS_EPS)
    return (y * g.astype(jnp.float32)).astype(x.dtype)


def rope_partial(t, cos, sin):
    half = ROT_DIM // 2
    c = cos[None, :, None, :]
    s = sin[None, :, None, :]
    x1 = t[..., :half]
    x2 = t[..., half:ROT_DIM]
    return jnp.concatenate([x1 * c - x2 * s, x2 * c + x1 * s, t[..., ROT_DIM:]], axis=-1)


def windowed_gqa(q, k, v, sink):
    b, l = q.shape[0], q.shape[1]
    pad = BLK - N_META
    lp = l + pad
    nb = lp // BLK
    qb = jnp.pad(q, ((0, 0), (pad, 0), (0, 0), (0, 0))).reshape(b, nb, BLK, N_KV_HEADS, Q_PER_KV, HEAD_DIM)
    kp = jnp.pad(k, ((0, 0), (pad + BLK, BLK), (0, 0), (0, 0))).reshape(b, nb + 2, BLK, N_KV_HEADS, HEAD_DIM)
    vp = jnp.pad(v, ((0, 0), (pad + BLK, BLK), (0, 0), (0, 0))).reshape(b, nb + 2, BLK, N_KV_HEADS, HEAD_DIM)
    band = lambda t: jnp.concatenate([t[:, :-2], t[:, 1:-1], t[:, 2:]], axis=2)
    kb, vb = band(kp), band(vp)
    km, vm = k[:, :N_META], v[:, :N_META]
    scale = HEAD_DIM ** -0.5
    s_band = jnp.einsum('bnqhgd,bnshd->bnhgqs', qb, kb).astype(jnp.float32) * scale
    s_meta = jnp.einsum('bnqhgd,bmhd->bnhgqm', qb, km).astype(jnp.float32) * scale
    qpos = jnp.arange(nb)[:, None] * BLK + jnp.arange(BLK)[None, :]
    kpos = (jnp.arange(nb)[:, None] - 1) * BLK + jnp.arange(3 * BLK)[None, :]
    kk = kpos[:, None, :]
    band_ok = (jnp.abs(qpos[:, :, None] - kk) <= WINDOW) & (kk >= BLK) & (kk < lp)
    s_band = jnp.where(band_ok[None, :, None, None], s_band, jnp.finfo(jnp.float32).min)
    sink_col = jnp.broadcast_to(
        sink.astype(jnp.float32).reshape(N_KV_HEADS, Q_PER_KV)[None, None, :, :, None, None],
        s_band.shape[:-1] + (1,))
    p = jax.nn.softmax(jnp.concatenate([s_meta, s_band, sink_col], axis=-1), axis=-1).astype(v.dtype)
    p_meta = p[..., :N_META]
    p_band = p[..., N_META:N_META + 3 * BLK]
    o = (jnp.einsum('bnhgqm,bmhd->bnqhgd', p_meta, vm)
         + jnp.einsum('bnhgqs,bnshd->bnqhgd', p_band, vb))
    return o.reshape(b, lp, ATTN_DIM)[:, pad:]


def mixer_block(h, w_in, conv_w, sink, w_attn_o, w_conv_o, w_out):
    b, l, _ = h.shape
    proj = h @ w_in
    idx = np.cumsum(IN_SIZES)[:-1].tolist()
    q, k, v, c_h, c_b, c_c, g_a, g_c = jnp.split(proj, idx, axis=-1)
    pos = jnp.arange(l, dtype=jnp.float32)
    inv_freq = ROPE_THETA ** (-jnp.arange(0, ROT_DIM, 2, dtype=jnp.float32) / ROT_DIM)
    ang = pos[:, None] * inv_freq[None, :]
    cos, sin = jnp.cos(ang).astype(h.dtype), jnp.sin(ang).astype(h.dtype)
    q = rope_partial(q.reshape(b, l, N_Q_HEADS, HEAD_DIM), cos, sin)
    k = rope_partial(k.reshape(b, l, N_KV_HEADS, HEAD_DIM), cos, sin)
    v = v.reshape(b, l, N_KV_HEADS, HEAD_DIM)
    y_attn = windowed_gqa(q, k, v, sink) @ w_attn_o
    u = c_c * c_h
    conv = lax.conv_general_dilated(
        u, conv_w[:, None, :], window_strides=(1,), padding=((CONV_K // 2, CONV_K // 2),),
        dimension_numbers=('NWC', 'WIO', 'NWC'), feature_group_count=CONV_DIM)
    y_conv = (c_b * conv) @ w_conv_o
    merged = jax.nn.sigmoid(g_a) * y_attn + jax.nn.sigmoid(g_c) * y_conv
    return merged @ w_out


def moe_ffn(h, router_w, router_b, w_gate_up, b_gate_up, w_down, b_down):
    t = h.shape[0]
    logits = (h @ router_w).astype(jnp.float32) + router_b.astype(jnp.float32)
    top_v, top_i = lax.top_k(logits, TOP_K)
    gates = jax.nn.softmax(top_v, axis=-1).astype(h.dtype)
    tk = t * TOP_K
    flat_e = top_i.reshape(-1)
    flat_tok = jnp.repeat(jnp.arange(t, dtype=jnp.int32), TOP_K)
    flat_g = gates.reshape(-1)
    order = jnp.argsort(flat_e)
    sorted_e = flat_e[order]
    counts = jnp.bincount(flat_e, length=N_EXPERTS)
    padded = (counts + MOE_BLK - 1) // MOE_BLK * MOE_BLK
    start = jnp.cumsum(counts) - counts
    cum_padded = jnp.cumsum(padded)
    start_padded = cum_padded - padded
    dest = start_padded[sorted_e] + (jnp.arange(tk) - start[sorted_e])
    n_blocks = (tk + N_EXPERTS * (MOE_BLK - 1) + MOE_BLK - 1) // MOE_BLK
    n_rows = n_blocks * MOE_BLK
    row_tok = jnp.full((n_rows,), t, jnp.int32).at[dest].set(flat_tok[order])
    row_gate = jnp.zeros((n_rows,), h.dtype).at[dest].set(flat_g[order])
    block_e = jnp.minimum(
        jnp.searchsorted(cum_padded, jnp.arange(n_blocks) * MOE_BLK, side='right'), N_EXPERTS - 1)
    h_pad = jnp.concatenate([h, jnp.zeros((1, h.shape[1]), h.dtype)], axis=0)
    xs = h_pad[row_tok].reshape(n_blocks, MOE_BLK, h.shape[1])

    def expert_block(args):
        xb, e = args
        gu = xb @ w_gate_up[e] + b_gate_up[e]
        gate = jnp.minimum(gu[:, :D_FF], SWIGLU_LIMIT)
        up = jnp.clip(gu[:, D_FF:], -SWIGLU_LIMIT, SWIGLU_LIMIT)
        act = (up + 1.0) * gate * jax.nn.sigmoid(SWIGLU_ALPHA * gate)
        return act @ w_down[e] + b_down[e]

    y_rows = lax.map(expert_block, (xs, block_e)).reshape(n_rows, h.shape[1])
    y = jax.ops.segment_sum(y_rows * row_gate[:, None], row_tok, num_segments=t + 1)
    return y[:t]


def setup_inputs(seed: int = 0) -> dict:
    key = jax.random.key(seed)
    ks = jax.random.split(key, 20)
    f32 = jnp.float32
    nrm = lambda k, shape, s: jax.random.normal(k, shape, f32) * s
    return {
        "x": nrm(ks[0], (BATCH, SEQ, D_MODEL), 1.0),
        "meta_tokens": nrm(ks[1], (N_META, D_MODEL), 1.0),
        "norm_mix_g": 1.0 + nrm(ks[2], (DEPTH, D_MODEL), 0.02),
        "w_in": nrm(ks[3], (DEPTH, D_MODEL, IN_DIM), D_MODEL ** -0.5),
        "conv_w": nrm(ks[4], (DEPTH, CONV_K, CONV_DIM), CONV_K ** -0.5),
        "sink": nrm(ks[5], (DEPTH, N_Q_HEADS), 0.5),
        "w_attn_o": nrm(ks[6], (DEPTH, ATTN_DIM, D_MODEL), ATTN_DIM ** -0.5),
        "w_conv_o": nrm(ks[7], (DEPTH, CONV_DIM, D_MODEL), CONV_DIM ** -0.5),
        "w_out": nrm(ks[8], (DEPTH, D_MODEL, D_MODEL), D_MODEL ** -0.5),
        "norm_ffn_g": 1.0 + nrm(ks[9], (DEPTH, D_MODEL), 0.02),
        "router_w": nrm(ks[10], (DEPTH, D_MODEL, N_EXPERTS), D_MODEL ** -0.5),
        "router_b": nrm(ks[11], (DEPTH, N_EXPERTS), 0.01),
        "w_gate_up": nrm(ks[12], (DEPTH, N_EXPERTS, D_MODEL, 2 * D_FF), D_MODEL ** -0.5),
        "b_gate_up": nrm(ks[13], (DEPTH, N_EXPERTS, 2 * D_FF), 0.02),
        "w_down": nrm(ks[14], (DEPTH, N_EXPERTS, D_FF, D_MODEL), D_FF ** -0.5),
        "b_down": nrm(ks[15], (DEPTH, N_EXPERTS, D_MODEL), 0.02),
        "norm_final_g": 1.0 + nrm(ks[16], (D_MODEL,), 0.02),
    }


def reference(x, meta_tokens, norm_mix_g, w_in, conv_w, sink, w_attn_o, w_conv_o, w_out,
              norm_ffn_g, router_w, router_b, w_gate_up, b_gate_up, w_down, b_down, norm_final_g):
    b = x.shape[0]
    meta = jnp.broadcast_to(meta_tokens.astype(x.dtype)[None], (b, N_META, x.shape[-1]))
    h = jnp.concatenate([meta, x], axis=1)
    l = h.shape[1]
    for i in range(DEPTH):
        h = h + mixer_block(rmsnorm(h, norm_mix_g[i]), w_in[i], conv_w[i], sink[i],
                            w_attn_o[i], w_conv_o[i], w_out[i])
        f = moe_ffn(rmsnorm(h, norm_ffn_g[i]).reshape(b * l, -1), router_w[i], router_b[i],
                    w_gate_up[i], b_gate_up[i], w_down[i], b_down[i])
        h = h + f.reshape(b, l, -1)
    return rmsnorm(h, norm_final_g)[:, N_META:]
```

```cpp
#include <hip/hip_runtime.h>
#include <stdint.h>
#include <stdio.h>

namespace {
typedef unsigned short bf16_t;
typedef short bf16x8 __attribute__((ext_vector_type(8)));
typedef float f32x4 __attribute__((ext_vector_type(4)));
typedef unsigned u32x4 __attribute__((ext_vector_type(4)));
typedef unsigned u32x2 __attribute__((ext_vector_type(2)));

constexpr int D = 2048, SEQ = 4096, NMETA = 16, T = 8192;
constexpr int TA = T + 128;
constexpr int ADIM = 1024, KVDIM = 256, CDIM = 1024, IN_DIM = 8704;
constexpr int OFF_Q = 0, OFF_K = 1024, OFF_V = 1280, OFF_CH = 1536, OFF_CB = 2560, OFF_CC = 3584, OFF_GA = 4608, OFF_GC = 6656;
constexpr int NE = 32, DFF = 2048;
constexpr int MOE_ROWS = 40960;
constexpr float RMS_EPS = 1e-5f;

constexpr size_t MiB = 1u << 20;
constexpr size_t WS_CTL = 0, CTL_BYTES = 1 * MiB;
constexpr size_t WS_HN = 1 * MiB;
constexpr size_t WS_PROJ = WS_HN + 34 * MiB;
constexpr size_t WS_AO = WS_PROJ + 140 * MiB;
constexpr size_t WS_CV = WS_AO + 16 * MiB;
constexpr size_t WS_M1 = WS_CV + 16 * MiB;
constexpr size_t WS_MERGED = WS_M1 + 64 * MiB;
constexpr size_t WS_H1 = WS_MERGED + 32 * MiB;
constexpr size_t WS_HN2 = WS_H1 + 64 * MiB;
constexpr size_t WS_TOKL = WS_HN2 + 32 * MiB;
constexpr size_t WS_GATEL = WS_TOKL + 1 * MiB;
constexpr size_t WS_POSE = WS_GATEL + 1 * MiB;
constexpr size_t WS_POSR = WS_POSE + 1 * MiB;
constexpr size_t WS_ACT = WS_POSR + 1 * MiB;
constexpr size_t WS_YR = WS_ACT + 160 * MiB;
constexpr size_t WS_END = WS_YR + 160 * MiB;
constexpr int CW_CNT = 1024;

__device__ __forceinline__ unsigned f2bf(float f) { unsigned u = __float_as_uint(f); return (u + 0x7fffu + ((u >> 16) & 1u)) >> 16; }
__device__ __forceinline__ unsigned pk2(float lo, float hi) { return f2bf(lo) | (f2bf(hi) << 16); }
__device__ __forceinline__ float bf2f(unsigned b) { return __uint_as_float(b << 16); }
__device__ __forceinline__ float bflo(unsigned w) { return __uint_as_float(w << 16); }
__device__ __forceinline__ float bfhi(unsigned w) { return __uint_as_float(w & 0xffff0000u); }
__device__ __forceinline__ float wave_sum(float v) {
#pragma unroll
    for (int o = 32; o >= 1; o >>= 1) v += __shfl_xor(v, o);
    return v;
}
__device__ __forceinline__ float sigmoidf_(float x) { return 1.0f / (1.0f + __expf(-x)); }

__device__ __forceinline__ void rms_row_bf16(const float* xrow, const float* g, bf16_t* orow, int lane) {
    const f32x4* xr = (const f32x4*)xrow; const f32x4* gr = (const f32x4*)g;
    f32x4 v[8]; float s = 0.f;
#pragma unroll
    for (int j = 0; j < 8; ++j) { v[j] = xr[lane + 64 * j]; s += (v[j].x * v[j].x + v[j].y * v[j].y) + (v[j].z * v[j].z + v[j].w * v[j].w); }
    s = wave_sum(s);
    const float rstd = 1.0f / sqrtf(s * (1.0f / D) + RMS_EPS);
    u32x2* o8 = (u32x2*)orow;
#pragma unroll
    for (int j = 0; j < 8; ++j) { const f32x4 gg = gr[lane + 64 * j]; u32x2 w; w.x = pk2(v[j].x * rstd * gg.x, v[j].y * rstd * gg.y); w.y = pk2(v[j].z * rstd * gg.z, v[j].w * rstd * gg.w); o8[lane + 64 * j] = w; }
}
__global__ __launch_bounds__(256) void k_rms1(const float* x, const float* meta, const float* g, bf16_t* hn) {
    const int lane = threadIdx.x & 63, gw = blockIdx.x * 4 + (threadIdx.x >> 6), ngw = gridDim.x * 4;
    for (int r = gw; r < TA; r += ngw) {
        bf16_t* orow = hn + (size_t)r * D;
        if (r < T) rms_row_bf16(x + (size_t)r * D, g, orow, lane);
        else if (r < T + NMETA) rms_row_bf16(meta + (size_t)(r - T) * D, g, orow, lane);
        else { u32x2* o8 = (u32x2*)orow; for (int j = 0; j < 8; ++j) o8[lane + 64 * j] = (u32x2){0u, 0u}; }
    }
}

template <class P> __global__ __launch_bounds__(256) void k_gemm(P p) {
    __shared__ __attribute__((aligned(16))) bf16_t sA[128 * 40];
    __shared__ __attribute__((aligned(16))) bf16_t sB[128 * 40];
    const int bx = blockIdx.x, by = blockIdx.y;
    typename P::State st;
    if (!p.init(st, bx, by)) return;
    const int tid = threadIdx.x, wid = tid >> 6, lane = tid & 63, wr = wid >> 1, wc = wid & 1, fr = lane & 15, fq = lane >> 4;
    const int ar = tid >> 1, ah = tid & 1, bn = tid & 127, kh = tid >> 7;
    const bf16_t* arow = p.a_row(st, by * 128 + ar);
    const float* bcol = p.b_col(st, bx * 128 + bn);
    const size_t ldb = p.ldb();
    const int K = p.K();
    f32x4 acc[4][4];
#pragma unroll
    for (int m = 0; m < 4; ++m)
#pragma unroll
        for (int n = 0; n < 4; ++n) acc[m][n] = (f32x4){0.f, 0.f, 0.f, 0.f};
    for (int k0 = 0; k0 < K; k0 += 32) {
        const u32x4 a0 = *(const u32x4*)(arow + k0 + ah * 16), a1 = *(const u32x4*)(arow + k0 + ah * 16 + 8);
        float bv[16];
#pragma unroll
        for (int kk = 0; kk < 16; ++kk) bv[kk] = bcol[(size_t)(k0 + kh * 16 + kk) * ldb];
        __syncthreads();
        *(u32x4*)(sA + ar * 40 + ah * 16) = a0; *(u32x4*)(sA + ar * 40 + ah * 16 + 8) = a1;
        u32x4 b0, b1;
        b0.x = pk2(bv[0], bv[1]); b0.y = pk2(bv[2], bv[3]); b0.z = pk2(bv[4], bv[5]); b0.w = pk2(bv[6], bv[7]);
        b1.x = pk2(bv[8], bv[9]); b1.y = pk2(bv[10], bv[11]); b1.z = pk2(bv[12], bv[13]); b1.w = pk2(bv[14], bv[15]);
        *(u32x4*)(sB + bn * 40 + kh * 16) = b0; *(u32x4*)(sB + bn * 40 + kh * 16 + 8) = b1;
        __syncthreads();
        bf16x8 At[4], Bt[4];
#pragma unroll
        for (int m = 0; m < 4; ++m) At[m] = *(const bf16x8*)(sA + (wr * 64 + m * 16 + fr) * 40 + fq * 8);
#pragma unroll
        for (int n = 0; n < 4; ++n) Bt[n] = *(const bf16x8*)(sB + (wc * 64 + n * 16 + fr) * 40 + fq * 8);
#pragma unroll
        for (int m = 0; m < 4; ++m)
#pragma unroll
            for (int n = 0; n < 4; ++n) acc[m][n] = __builtin_amdgcn_mfma_f32_16x16x32_bf16(At[m], Bt[n], acc[m][n], 0, 0, 0);
    }
    p.epi(st, acc, by * 128 + wr * 64 + fq * 4, bx * 128 + wc * 64 + fr);
}

struct PolProj {
    const bf16_t* hn; const float* w; bf16_t* proj;
    struct State {}; __device__ bool init(State&, int, int) const { return true; }
    __device__ const bf16_t* a_row(const State& st, int r) const { return hn + (size_t)r * D; }
    __device__ const float* b_col(const State& st, int c) const { return w + c; }
    __device__ size_t ldb() const { return IN_DIM; }
    __device__ int K() const { return D; }
    __device__ void epi(const State& st, const f32x4 (&acc)[4][4], int row0, int col0) const {
#pragma unroll
        for (int m = 0; m < 4; ++m)
#pragma unroll
            for (int n = 0; n < 4; ++n)
#pragma unroll
                for (int j = 0; j < 4; ++j) proj[(size_t)(row0 + m * 16 + j) * IN_DIM + col0 + n * 16] = (bf16_t)f2bf(acc[m][n][j]);
    }
};
struct PolM1 {
    const bf16_t* a; const float* w; const bf16_t* proj; float* m1;
    struct State {}; __device__ bool init(State&, int, int) const { return true; }
    __device__ const bf16_t* a_row(const State& st, int r) const { return a + (size_t)r * ADIM; }
    __device__ const float* b_col(const State& st, int c) const { return w + c; }
    __device__ size_t ldb() const { return D; }
    __device__ int K() const { return ADIM; }
    __device__ void epi(const State& st, const f32x4 (&acc)[4][4], int row0, int col0) const {
#pragma unroll
        for (int m = 0; m < 4; ++m)
#pragma unroll
            for (int n = 0; n < 4; ++n)
#pragma unroll
                for (int j = 0; j < 4; ++j) { const int r = row0 + m * 16 + j, c = col0 + n * 16;
                    const float g = bf2f(proj[(size_t)r * IN_DIM + OFF_GA + c]); m1[(size_t)r * D + c] = sigmoidf_(g) * acc[m][n][j]; }
    }
};
struct PolMerged {
    const bf16_t* a; const float* w; const bf16_t* proj; const float* m1; bf16_t* merged;
    struct State {}; __device__ bool init(State&, int, int) const { return true; }
    __device__ const bf16_t* a_row(const State& st, int r) const { return a + (size_t)r * CDIM; }
    __device__ const float* b_col(const State& st, int c) const { return w + c; }
    __device__ size_t ldb() const { return D; }
    __device__ int K() const { return CDIM; }
    __device__ void epi(const State& st, const f32x4 (&acc)[4][4], int row0, int col0) const {
#pragma unroll
        for (int m = 0; m < 4; ++m)
#pragma unroll
            for (int n = 0; n < 4; ++n)
#pragma unroll
                for (int j = 0; j < 4; ++j) { const int r = row0 + m * 16 + j, c = col0 + n * 16;
                    const float g = bf2f(proj[(size_t)r * IN_DIM + OFF_GC + c]); merged[(size_t)r * D + c] = (bf16_t)f2bf(m1[(size_t)r * D + c] + sigmoidf_(g) * acc[m][n][j]); }
    }
};
struct PolH1 {
    const bf16_t* a; const float* w; const float* x; float* h1;
    struct State {}; __device__ bool init(State&, int, int) const { return true; }
    __device__ const bf16_t* a_row(const State& st, int r) const { return a + (size_t)r * D; }
    __device__ const float* b_col(const State& st, int c) const { return w + c; }
    __device__ size_t ldb() const { return D; }
    __device__ int K() const { return D; }
    __device__ void epi(const State& st, const f32x4 (&acc)[4][4], int row0, int col0) const {
#pragma unroll
        for (int m = 0; m < 4; ++m)
#pragma unroll
            for (int n = 0; n < 4; ++n)
#pragma unroll
                for (int j = 0; j < 4; ++j) { const size_t o = (size_t)(row0 + m * 16 + j) * D + col0 + n * 16; h1[o] = x[o] + acc[m][n][j]; }
    }
};
struct MoeMap {
    int e, j0, cnt, poff;
    __device__ bool find(const unsigned* ctl, int by) {
        int off = 0;
        for (int i = 0; i < NE; ++i) { const int c = (int)ctl[CW_CNT + 64 * i]; const int pc = (c + 255) & ~255;
            if (by * 128 < off + pc) { e = i; j0 = by * 128 - off; cnt = c; poff = off; return true; } off += pc; }
        return false;
    }
};
struct PolAct {
    const bf16_t* hn2; const float* wgu; const float* bgu; const unsigned* ctl; const int* tokl; bf16_t* act;
    struct State { MoeMap mm; int bx_; };
    __device__ bool init(State& st, int bx, int by) const { st.bx_ = bx; return st.mm.find(ctl, by); }
    __device__ const bf16_t* a_row(const State& st, int r) const { const int j = st.mm.j0 + (r & 127); const int t = tokl[st.mm.e * T + (j < st.mm.cnt ? j : 0)]; return hn2 + (size_t)t * D; }
    __device__ static int jcol(int c) { return ((c >> 6) & 1) * 32 + ((c >> 5) & 1) * 16 + (c & 15); }
    __device__ const float* b_col(const State& st, int c) const { const int cc = c & 127; return wgu + (size_t)st.mm.e * D * (2 * DFF) + ((cc >> 4) & 1) * DFF + st.bx_ * 64 + jcol(cc); }
    __device__ size_t ldb() const { return 2 * DFF; }
    __device__ int K() const { return D; }
    __device__ void epi(const State& st, const f32x4 (&acc)[4][4], int row0, int col0) const {
        const int c0 = col0 & 127;
#pragma unroll
        for (int m = 0; m < 4; ++m)
#pragma unroll
            for (int np = 0; np < 2; ++np) { const int j = st.bx_ * 64 + jcol(c0 + np * 32);
                const float bg = bgu[st.mm.e * 2 * DFF + j], bu = bgu[st.mm.e * 2 * DFF + DFF + j];
#pragma unroll
                for (int jj = 0; jj < 4; ++jj) { const int prow = st.mm.poff + st.mm.j0 + (row0 & 127) + m * 16 + jj;
                    const float gate = fminf(acc[m][2 * np][jj] + bg, 7.0f), up = fminf(fmaxf(acc[m][2 * np + 1][jj] + bu, -7.0f), 7.0f);
                    act[(size_t)prow * DFF + j] = (bf16_t)f2bf((up + 1.0f) * gate * sigmoidf_(1.702f * gate)); } }
    }
};
struct PolY {
    const bf16_t* act; const float* wd; const float* bd; const unsigned* ctl; const float* gatel; bf16_t* yr;
    struct State { MoeMap mm; };
    __device__ bool init(State& st, int, int by) const { return st.mm.find(ctl, by); }
    __device__ const bf16_t* a_row(const State& st, int r) const { return act + (size_t)(st.mm.poff + st.mm.j0 + (r & 127)) * DFF; }
    __device__ const float* b_col(const State& st, int c) const { return wd + (size_t)st.mm.e * DFF * D + c; }
    __device__ size_t ldb() const { return D; }
    __device__ int K() const { return DFF; }
    __device__ void epi(const State& st, const f32x4 (&acc)[4][4], int row0, int col0) const {
#pragma unroll
        for (int m = 0; m < 4; ++m)
#pragma unroll
            for (int jj = 0; jj < 4; ++jj) { const int j = st.mm.j0 + (row0 & 127) + m * 16 + jj; const float g = (j < st.mm.cnt) ? gatel[st.mm.e * T + j] : 0.f;
#pragma unroll
                for (int n = 0; n < 4; ++n) { const int c = col0 + n * 16; yr[(size_t)(st.mm.poff + j) * D + c] = (bf16_t)f2bf((acc[m][n][jj] + bd[st.mm.e * D + c]) * g); } }
    }
};

__constant__ float c_invrev[8] = {0.15915494309189535f, 0.03086376340470123f, 0.005985185712713705f, 0.001160663641240061f,
                                  0.00022507907903927653f, 4.364795279280289e-05f, 8.464330808241401e-06f, 1.6414262627950345e-06f};
__global__ __launch_bounds__(256) void k_rope(bf16_t* proj) {
    const int idx = blockIdx.x * 256 + threadIdx.x;
    if (idx >= (T + NMETA) * 160) return;
    const int r = idx / 160, hi = idx % 160, h = hi >> 3, i = hi & 7;
    const int pos = (r < T) ? (NMETA + (r & (SEQ - 1))) : (r - T);
    float rev = (float)pos * c_invrev[i]; rev -= floorf(rev);
    const float sn = __builtin_amdgcn_sinf(rev), cs = __builtin_amdgcn_cosf(rev);
    bf16_t* p = proj + (size_t)r * IN_DIM + h * 64 + i;
    const float x1 = bf2f(p[0]), x2 = bf2f(p[8]);
    p[0] = (bf16_t)f2bf(x1 * cs - x2 * sn); p[8] = (bf16_t)f2bf(x2 * cs + x1 * sn);
}

__global__ __launch_bounds__(256) void k_attn(const bf16_t* proj, const float* sink, bf16_t* ao) {
    const int lane = threadIdx.x & 63, gw = blockIdx.x * 4 + (threadIdx.x >> 6);
    if (gw >= T * 16) return;
    const int r = gw >> 4, h = gw & 15, hk = h >> 2, b = r >> 12, s = r & (SEQ - 1);
    const float q = bf2f(proj[(size_t)r * IN_DIM + OFF_Q + h * 64 + lane]) * 0.125f;
    float m = sink[h], l = 1.0f, o = 0.f;
    const int lo = (s - 128 < 0) ? 0 : s - 128, hi = (s + 128 > SEQ - 1) ? SEQ - 1 : s + 128;
    const int nk = NMETA + (hi - lo + 1);
    for (int j = 0; j < nk; ++j) {
        const int kr = (j < NMETA) ? (T + j) : (b * SEQ + lo + (j - NMETA));
        const bf16_t* kp = proj + (size_t)kr * IN_DIM;
        const float sc = wave_sum(q * bf2f(kp[OFF_K + hk * 64 + lane]));
        const float v = bf2f(kp[OFF_V + hk * 64 + lane]);
        const float mn = fmaxf(m, sc), a = __expf(m - mn), p = __expf(sc - mn);
        l = l * a + p; o = o * a + p * v; m = mn;
    }
    ao[(size_t)r * ADIM + h * 64 + lane] = (bf16_t)f2bf(o / l);
}

__global__ __launch_bounds__(256) void k_conv(const bf16_t* proj, const float* cw, bf16_t* cv) {
    const int idx = blockIdx.x * 256 + threadIdx.x;
    if (idx >= T * CDIM) return;
    const int r = idx >> 10, c = idx & 1023, s = r & (SEQ - 1);
    const bf16_t* p = proj + (size_t)r * IN_DIM;
    const float u1 = bf2f(p[OFF_CC + c]) * bf2f(p[OFF_CH + c]);
    const bf16_t* pm = (s == 0) ? proj + (size_t)(T + NMETA - 1) * IN_DIM : p - IN_DIM;
    const float u0 = bf2f(pm[OFF_CC + c]) * bf2f(pm[OFF_CH + c]);
    float u2 = 0.f; if (s != SEQ - 1) { const bf16_t* pp = p + IN_DIM; u2 = bf2f(pp[OFF_CC + c]) * bf2f(pp[OFF_CH + c]); }
    const float conv = u0 * cw[c] + u1 * cw[CDIM + c] + u2 * cw[2 * CDIM + c];
    cv[(size_t)r * CDIM + c] = (bf16_t)f2bf(bf2f(p[OFF_CB + c]) * conv);
}

__global__ __launch_bounds__(256) void k_route(const float* h1, const float* g, const float* rw, const float* rb, bf16_t* hn2,
                                               unsigned* ctl, int* tokl, float* gatel, int* pose, int* posr) {
    const int lane = threadIdx.x & 63, gw = blockIdx.x * 4 + (threadIdx.x >> 6), ngw = gridDim.x * 4;
    for (int t = gw; t < T; t += ngw) {
        const f32x4* xr = (const f32x4*)(h1 + (size_t)t * D); const f32x4* gr = (const f32x4*)g;
        f32x4 v[8]; float s = 0.f;
#pragma unroll
        for (int j = 0; j < 8; ++j) { v[j] = xr[lane + 64 * j]; s += (v[j].x * v[j].x + v[j].y * v[j].y) + (v[j].z * v[j].z + v[j].w * v[j].w); }
        s = wave_sum(s);
        const float rstd = 1.0f / sqrtf(s * (1.0f / D) + RMS_EPS);
        u32x2* o8 = (u32x2*)(hn2 + (size_t)t * D);
        float lg[32];
#pragma unroll
        for (int e = 0; e < 32; ++e) lg[e] = 0.f;
#pragma unroll
        for (int j = 0; j < 8; ++j) { const f32x4 gg = gr[lane + 64 * j];
            f32x4 y; y.x = v[j].x * rstd * gg.x; y.y = v[j].y * rstd * gg.y; y.z = v[j].z * rstd * gg.z; y.w = v[j].w * rstd * gg.w;
            u32x2 w; w.x = pk2(y.x, y.y); w.y = pk2(y.z, y.w); o8[lane + 64 * j] = w;
#pragma unroll
            for (int i = 0; i < 4; ++i) { const f32x4* wr = (const f32x4*)(rw + (size_t)((lane + 64 * j) * 4 + i) * NE); const float yi = y[i];
#pragma unroll
                for (int e4 = 0; e4 < 8; ++e4) { const f32x4 ww = wr[e4]; lg[e4 * 4 + 0] += yi * ww.x; lg[e4 * 4 + 1] += yi * ww.y; lg[e4 * 4 + 2] += yi * ww.z; lg[e4 * 4 + 3] += yi * ww.w; } } }
#pragma unroll
        for (int e = 0; e < 32; ++e) lg[e] = wave_sum(lg[e]);
        float mine = -3.0e38f;
#pragma unroll
        for (int e = 0; e < 32; ++e) if (lane == e) mine = lg[e] + rb[e];
        int se[4]; float sv[4];
#pragma unroll
        for (int k = 0; k < 4; ++k) {
            float bv = mine; int bi = lane;
#pragma unroll
            for (int o = 32; o >= 1; o >>= 1) { const float ov = __shfl_xor(bv, o); const int oi = __shfl_xor(bi, o); if (ov > bv || (ov == bv && oi < bi)) { bv = ov; bi = oi; } }
            se[k] = bi; sv[k] = bv; if (lane == bi) mine = -3.0e38f;
        }
        const float e1 = __expf(sv[1] - sv[0]), e2 = __expf(sv[2] - sv[0]), e3 = __expf(sv[3] - sv[0]), inv = 1.0f / (1.0f + e1 + e2 + e3);
        if (lane < 4) {
            const int e = (lane == 0) ? se[0] : (lane == 1) ? se[1] : (lane == 2) ? se[2] : se[3];
            const float gt = ((lane == 0) ? 1.0f : (lane == 1) ? e1 : (lane == 2) ? e2 : e3) * inv;
            const int rank = (int)atomicAdd(&ctl[CW_CNT + 64 * e], 1u);
            tokl[e * T + rank] = t; gatel[e * T + rank] = gt; pose[t * 4 + lane] = e; posr[t * 4 + lane] = rank;
        }
    }
}

__global__ __launch_bounds__(256) void k_final(const float* h1, const bf16_t* yr, const unsigned* ctl, const int* pose, const int* posr, const float* g, float* out) {
    const int lane = threadIdx.x & 63, gw = blockIdx.x * 4 + (threadIdx.x >> 6), ngw = gridDim.x * 4;
    int poff[NE]; { int off = 0;
#pragma unroll
        for (int i = 0; i < NE; ++i) { poff[i] = off; off += ((int)ctl[CW_CNT + 64 * i] + 255) & ~255; } }
    for (int t = gw; t < T; t += ngw) {
        const f32x4* xr = (const f32x4*)(h1 + (size_t)t * D); const f32x4* gr = (const f32x4*)g;
        f32x4 v[8];
#pragma unroll
        for (int j = 0; j < 8; ++j) v[j] = xr[lane + 64 * j];
        for (int k = 0; k < 4; ++k) {
            const int e = pose[t * 4 + k], rk = posr[t * 4 + k]; int po = 0;
#pragma unroll
            for (int i = 0; i < NE; ++i) po = (i == e) ? poff[i] : po;
            const u32x2* y8 = (const u32x2*)(yr + (size_t)(po + rk) * D);
#pragma unroll
            for (int j = 0; j < 8; ++j) { const u32x2 w = y8[lane + 64 * j]; v[j].x += bflo(w.x); v[j].y += bfhi(w.x); v[j].z += bflo(w.y); v[j].w += bfhi(w.y); }
        }
        float s = 0.f;
#pragma unroll
        for (int j = 0; j < 8; ++j) s += (v[j].x * v[j].x + v[j].y * v[j].y) + (v[j].z * v[j].z + v[j].w * v[j].w);
        s = wave_sum(s);
        const float rstd = 1.0f / sqrtf(s * (1.0f / D) + RMS_EPS);
        f32x4* orow = (f32x4*)(out + (size_t)t * D);
#pragma unroll
        for (int j = 0; j < 8; ++j) { const f32x4 gg = gr[lane + 64 * j]; f32x4 y; y.x = v[j].x * rstd * gg.x; y.y = v[j].y * rstd * gg.y; y.z = v[j].z * rstd * gg.z; y.w = v[j].w * rstd * gg.w; orow[lane + 64 * j] = y; }
    }
}
}

extern "C" void kernel_launch(void* const* d_in, const int* in_sizes, int n_in, void* d_out, int out_size, void* d_ws, size_t ws_size, hipStream_t stream) {
    if (n_in != 17 || out_size != T * D || ws_size < WS_END) { fprintf(stderr, "kernel_launch: unexpected shapes (n_in %d out %d ws %zu)\n", n_in, out_size, ws_size); return; }
    const float* x = (const float*)d_in[0]; const float* meta = (const float*)d_in[1]; const float* g_mix = (const float*)d_in[2]; const float* w_in = (const float*)d_in[3];
    const float* conv_w = (const float*)d_in[4]; const float* sink = (const float*)d_in[5]; const float* w_ao = (const float*)d_in[6]; const float* w_co = (const float*)d_in[7];
    const float* w_out = (const float*)d_in[8]; const float* g_ffn = (const float*)d_in[9]; const float* rw = (const float*)d_in[10]; const float* rb = (const float*)d_in[11];
    const float* wgu = (const float*)d_in[12]; const float* bgu = (const float*)d_in[13]; const float* wd = (const float*)d_in[14]; const float* bd = (const float*)d_in[15];
    const float* g_fin = (const float*)d_in[16];
    unsigned char* ws = (unsigned char*)d_ws;
    unsigned* ctl = (unsigned*)(ws + WS_CTL);
    bf16_t* hn = (bf16_t*)(ws + WS_HN); bf16_t* proj = (bf16_t*)(ws + WS_PROJ); bf16_t* ao = (bf16_t*)(ws + WS_AO); bf16_t* cv = (bf16_t*)(ws + WS_CV);
    float* m1 = (float*)(ws + WS_M1); bf16_t* merged = (bf16_t*)(ws + WS_MERGED); float* h1 = (float*)(ws + WS_H1); bf16_t* hn2 = (bf16_t*)(ws + WS_HN2);
    int* tokl = (int*)(ws + WS_TOKL); float* gatel = (float*)(ws + WS_GATEL); int* pose = (int*)(ws + WS_POSE); int* posr = (int*)(ws + WS_POSR);
    bf16_t* act = (bf16_t*)(ws + WS_ACT); bf16_t* yr = (bf16_t*)(ws + WS_YR);
    hipMemsetAsync(ws + WS_CTL, 0, CTL_BYTES, stream);
    k_rms1<<<1024, 256, 0, stream>>>(x, meta, g_mix, hn);
    { PolProj p{hn, w_in, proj}; k_gemm<PolProj><<<dim3(IN_DIM / 128, TA / 128), 256, 0, stream>>>(p); }
    k_rope<<<((T + NMETA) * 160 + 255) / 256, 256, 0, stream>>>(proj);
    k_attn<<<T * 16 / 4, 256, 0, stream>>>(proj, sink, ao);
    k_conv<<<T * CDIM / 256, 256, 0, stream>>>(proj, conv_w, cv);
    { PolM1 p{ao, w_ao, proj, m1}; k_gemm<PolM1><<<dim3(D / 128, T / 128), 256, 0, stream>>>(p); }
    { PolMerged p{cv, w_co, proj, m1, merged}; k_gemm<PolMerged><<<dim3(D / 128, T / 128), 256, 0, stream>>>(p); }
    { PolH1 p{merged, w_out, x, h1}; k_gemm<PolH1><<<dim3(D / 128, T / 128), 256, 0, stream>>>(p); }
    k_route<<<1024, 256, 0, stream>>>(h1, g_ffn, rw, rb, hn2, ctl, tokl, gatel, pose, posr);
    { PolAct p{hn2, wgu, bgu, ctl, tokl, act}; k_gemm<PolAct><<<dim3(DFF / 64, MOE_ROWS / 128), 256, 0, stream>>>(p); }
    { PolY p{act, wd, bd, ctl, gatel, yr}; k_gemm<PolY><<<dim3(D / 128, MOE_ROWS / 128), 256, 0, stream>>>(p); }
    k_final<<<1024, 256, 0, stream>>>(h1, yr, ctl, pose, posr, g_fin, (float*)d_out);
}
```

```cpp
#include <hip/hip_runtime.h>
#include <stdint.h>
#include <stdio.h>

namespace {
#define LAS __attribute__((address_space(3)))
typedef unsigned short bf16_t;
typedef short bf16x8 __attribute__((ext_vector_type(8)));
typedef float f32x4 __attribute__((ext_vector_type(4)));
typedef float f32x2 __attribute__((ext_vector_type(2)));
typedef unsigned u32x4 __attribute__((ext_vector_type(4)));
typedef unsigned u32x2 __attribute__((ext_vector_type(2)));

constexpr int NT = 512, NWAVES = 8;
constexpr int D = 2048, SEQ = 4096, NMETA = 16, T = 8192;
constexpr int TA = T + 256;
constexpr int ADIM = 1024, KVDIM = 256, CDIM = 1024, IN_DIM = 8704;
constexpr int OFF_Q = 0, OFF_K = 1024, OFF_V = 1280, OFF_CH = 1536, OFF_CB = 2560, OFF_CC = 3584, OFF_GA = 4608, OFF_GC = 6656;
constexpr int NE = 32, DFF = 2048, ECAP = 8192;
constexpr float RMS_EPS = 1e-5f;
constexpr float WSCALE = 32.0f, WSCALE_INV = 1.0f / 32.0f;
constexpr bool P5_FP8 = true;
constexpr float MSCALE = 8.0f;
constexpr bool P1_QKV_FP8 = true;
constexpr float HSCALE = 8.0f;
constexpr int QKV_COLS = 1536;
constexpr float YSCALE = 16.0f, YSCALE_INV = 1.0f / 16.0f;

constexpr size_t MiB = 1u << 20;
constexpr size_t WS_CTL = 0, CTL_BYTES = 1 * MiB;
constexpr size_t WS_HN = 1 * MiB;
constexpr size_t WS_PROJ = WS_HN + 35 * MiB;
constexpr size_t WS_AC = WS_PROJ + 142 * MiB;
constexpr size_t WS_M1 = WS_AC + 32 * MiB;
constexpr size_t WS_HN8 = WS_M1;
constexpr size_t WS_WIN8 = WS_M1 + 32 * MiB;
constexpr size_t WS_MERGED = WS_M1 + 64 * MiB;
constexpr size_t WS_H1 = WS_MERGED + 32 * MiB;
constexpr size_t WS_GATEL = WS_H1 + 64 * MiB;
constexpr size_t WS_POS = WS_GATEL + 1 * MiB;
constexpr size_t WS_WRT = WS_POS + 512 * 1024;
constexpr size_t WS_XS = WS_POS + 1 * MiB;
constexpr size_t WS_ACT = WS_XS + 1024 * MiB;
constexpr size_t WS_WIN = WS_ACT + 1024 * MiB;
constexpr size_t WS_WAC = WS_WIN + 34 * MiB;
constexpr size_t WS_WOUT = WS_WAC + 8 * MiB;
constexpr size_t WS_WGU = WS_WOUT + 8 * MiB;
constexpr size_t WS_WD = WS_WGU + 512 * MiB;
constexpr size_t WS_END = WS_WD + 256 * MiB;
constexpr int CW_CNT = 1024;
constexpr int CW_CQ = 3584;
constexpr int CW_BAR = 4096;

constexpr int RING_BYTES = 131072, MISC_OFF = RING_BYTES + 320, LDS_BYTES = 147456;

__device__ __forceinline__ unsigned f2bf(float f) { unsigned u = __float_as_uint(f); return (u + 0x7fffu + ((u >> 16) & 1u)) >> 16; }
__device__ __forceinline__ unsigned pk2(float lo, float hi) { return f2bf(lo) | (f2bf(hi) << 16); }
__device__ __forceinline__ float bf2f(unsigned b) { return __uint_as_float(b << 16); }
__device__ __forceinline__ float bflo(unsigned w) { return __uint_as_float(w << 16); }
__device__ __forceinline__ float bfhi(unsigned w) { return __uint_as_float(w & 0xffff0000u); }
__device__ __forceinline__ float wave_sum(float v) {
#pragma unroll
    for (int o = 32; o >= 1; o >>= 1) v += __shfl_xor(v, o);
    return v;
}
__device__ __forceinline__ float sigmoidf_(float x) { return __builtin_amdgcn_rcpf(1.0f + __builtin_amdgcn_exp2f(x * -1.4426950408889634f)); }

__constant__ float c_invrev[8] = {0.15915494309189535f, 0.03086376340470123f, 0.005985185712713705f, 0.001160663641240061f,
                                  0.00022507907903927653f, 4.364795279280289e-05f, 8.464330808241401e-06f, 1.6414262627950345e-06f};

#define XB_TMO      128
#define XB_XCNT(j)  (256  + 64 * (j))
#define XB_XSUB(j)  (1280 + 64 * (j))
#define XB_XGEN(j)  (2304 + 64 * (j))
#define XB_TOP      3328
#define XB_TOPGEN   3392
#define XCD_BAR_WORDS 3456
#define XB_SPIN_CAP (1u << 18)

__device__ __forceinline__ unsigned xb_ld(unsigned* p)              { return __hip_atomic_load(p, __ATOMIC_RELAXED, __HIP_MEMORY_SCOPE_AGENT); }
__device__ __forceinline__ unsigned xb_add(unsigned* p, unsigned v) { return __hip_atomic_fetch_add(p, v, __ATOMIC_RELAXED, __HIP_MEMORY_SCOPE_AGENT); }
__device__ __forceinline__ unsigned xb_xcc_id() { return (unsigned)__builtin_amdgcn_s_getreg((3 << 11) | 20) & 0xFu; }
#define XB_SPIN(cond, bar) do { unsigned _sp = 0; while (cond) { __builtin_amdgcn_s_sleep(1); \
    if ((++_sp & 255u) == 0u) { if (xb_ld(&(bar)[XB_TMO])) break; if (_sp > XB_SPIN_CAP) { atomicAdd(&(bar)[XB_TMO], 1u); break; } } } } while (0)

struct XcdBarrier {
    unsigned* bar; unsigned x;
    volatile LAS unsigned* st;
};

__device__ __forceinline__ XcdBarrier xcd_barrier_post(unsigned* bar, volatile LAS unsigned* st) {
    XcdBarrier b; b.bar = bar; b.x = xb_xcc_id(); b.st = st;
    if (threadIdx.x == 0) (void)xb_add(&bar[XB_XCNT(b.x)], 1u);
    return b;
}
__device__ __forceinline__ void xcd_barrier_complete(unsigned* bar, unsigned x, unsigned& nloc, unsigned& nx) {
    const unsigned G = gridDim.x * gridDim.y * gridDim.z;
    unsigned sum, cnt, mine, sp = 0u;
    for (;;) {
        sum = 0u; cnt = 0u; mine = 0u;
#pragma unroll
        for (unsigned j = 0; j < 16; ++j) { const unsigned c = xb_ld(&bar[XB_XCNT(j)]); sum += c; cnt += (c > 0u) ? 1u : 0u; mine = (j == x) ? c : mine; }
        if (sum == G) break;
        __builtin_amdgcn_s_sleep(1);
        if ((++sp & 255u) == 0u) { if (xb_ld(&bar[XB_TMO])) break; if (sp > XB_SPIN_CAP) { atomicAdd(&bar[XB_TMO], 1u); break; } }
    }
    nloc = mine > 0u ? mine : 1u; nx = cnt > 0u ? cnt : 1u;
}

__device__ __forceinline__ void xcd_barrier(const XcdBarrier& b) {
    asm volatile("s_waitcnt vmcnt(0)" ::: "memory");
    __syncthreads();
    if (threadIdx.x == 0) {
        unsigned* bar = b.bar;
        __builtin_amdgcn_s_waitcnt(0);
        unsigned nloc = b.st[0], nx = b.st[1];
        if (nloc == 0u) { xcd_barrier_complete(bar, b.x, nloc, nx); b.st[0] = nloc; b.st[1] = nx; }
        const unsigned old = xb_add(&bar[XB_XSUB(b.x)], 1u);
        const unsigned gen = old / nloc;
        if (old + 1u == (gen + 1u) * nloc) {
            __builtin_amdgcn_fence(__ATOMIC_RELEASE, "agent");
            asm volatile("s_waitcnt vmcnt(0)" ::: "memory");
            const unsigned og = xb_add(&bar[XB_TOP], 1u);
            const unsigned tg = og / nx;
            if (og + 1u == (tg + 1u) * nx) xb_add(&bar[XB_TOPGEN], 1u);
            else XB_SPIN(xb_ld(&bar[XB_TOPGEN]) == tg, bar);
            __builtin_amdgcn_fence(__ATOMIC_ACQUIRE, "agent");
            xb_add(&bar[XB_XGEN(b.x)], 1u);
            asm volatile("s_waitcnt vmcnt(0)" ::: "memory");
        } else {
            XB_SPIN(xb_ld(&bar[XB_XGEN(b.x)]) == gen, bar);
            __builtin_amdgcn_fence(__ATOMIC_ACQUIRE, "agent");
            asm volatile("s_waitcnt vmcnt(0)" ::: "memory");
        }
    }
    __syncthreads();
}

__device__ __forceinline__ void rms_row_bf16(const float* xrow, const float* g, bf16_t* orow, int lane, unsigned char* orow8 = nullptr) {
    const f32x4* xr = (const f32x4*)xrow; const f32x4* gr = (const f32x4*)g;
    f32x4 v[8]; float s = 0.f;
#pragma unroll
    for (int j = 0; j < 8; ++j) { v[j] = xr[lane + 64 * j]; s += (v[j].x * v[j].x + v[j].y * v[j].y) + (v[j].z * v[j].z + v[j].w * v[j].w); }
    s = wave_sum(s);
    const float rstd = 1.0f / sqrtf(s * (1.0f / D) + RMS_EPS);
    u32x2* o8 = (u32x2*)orow;
#pragma unroll
    for (int j = 0; j < 8; ++j) { const f32x4 gg = gr[lane + 64 * j]; const float a0 = v[j].x * rstd * gg.x, a1 = v[j].y * rstd * gg.y, a2 = v[j].z * rstd * gg.z, a3 = v[j].w * rstd * gg.w;
        u32x2 w; w.x = pk2(a0, a1); w.y = pk2(a2, a3); o8[lane + 64 * j] = w;
        if (orow8) { int r8 = 0; r8 = __builtin_amdgcn_cvt_pk_fp8_f32(a0 * HSCALE, a1 * HSCALE, r8, false); r8 = __builtin_amdgcn_cvt_pk_fp8_f32(a2 * HSCALE, a3 * HSCALE, r8, true); ((unsigned*)orow8)[lane + 64 * j] = (unsigned)r8; } }
}

namespace pg8 {
constexpr int BM = 256, BK = 64, HALF = 128, HTB = HALF * BK * 2  , STAGE_BYTES = 8 * HTB, NXCD = 8, WGM = 8;
__host__ __device__ __forceinline__ int lds_byte(int r, int c) { const int st = (r >> 4) * 2 + (c >> 5), rr = r & 15, cc = c & 31, ob = rr * 64 + cc * 2; return st * 1024 + (ob ^ (((ob >> 9) & 1) << 5)); }
__host__ __device__ __forceinline__ void stage_rc(int b, int& R, int& C) { const int st = b / 1024, sb = b % 1024, swz = sb ^ (((sb >> 9) & 1) << 5); R = (st >> 1) * 16 + swz / 64; C = (st & 1) * 32 + (swz % 64) / 2; }
__host__ __device__ __forceinline__ int perm32(int rho) { const int n = rho >> 4, i = rho & 15; return 8 * (i >> 2) + 4 * n + (i & 3); }

struct Unit { const char* a0; const char* a1; const char* b0; const char* b1; int row0, col0, e; };
typedef int v8i __attribute__((ext_vector_type(8)));
typedef int v4i __attribute__((ext_vector_type(4)));
__device__ __forceinline__ v8i cat8(bf16x8 a, bf16x8 b) { const v4i x = __builtin_bit_cast(v4i, a), y = __builtin_bit_cast(v4i, b); return (v8i){x[0], x[1], x[2], x[3], y[0], y[1], y[2], y[3]}; }
__device__ __forceinline__ unsigned pk4_fp8(float a, float b, float c, float d) { int r = 0; r = __builtin_amdgcn_cvt_pk_fp8_f32(a, b, r, false); r = __builtin_amdgcn_cvt_pk_fp8_f32(c, d, r, true); return (unsigned)r; }
__device__ __forceinline__ unsigned cvt_pk_bf16(float lo, float hi) { unsigned r; asm volatile("v_cvt_pk_bf16_f32 %0, %1, %2" : "=v"(r) : "v"(lo), "v"(hi)); return r; }

__device__ __forceinline__ int xcd_remap(int L, int nwg) { const int q = nwg / NXCD, r = nwg % NXCD, xcd = L % NXCD, off = L / NXCD; return (xcd < r ? xcd * (q + 1) : r * (q + 1) + (xcd - r) * q) + off; }

__device__ __forceinline__ void glds16_s(const char* sbase, unsigned voff, unsigned lds_dst) {
    unsigned keep;
    asm volatile("s_mov_b32 %0, m0\n\ts_mov_b32 m0, %3\n\ts_nop 2\n\tglobal_load_lds_dwordx4 %1, %2\n\ts_mov_b32 m0, %0" : "=&s"(keep) : "v"(voff), "s"(sbase), "s"(lds_dst) : "memory");
}
__device__ __forceinline__ void mfma_fp8_inplace(f32x4& c, v8i a, v8i b, int scale) {
    asm volatile("v_mfma_scale_f32_16x16x128_f8f6f4 %0, %1, %2, %0, %3, %3 op_sel_hi:[0,0,0]" : "+v"(c) : "v"(a), "v"(b), "v"(scale));
}
__device__ __forceinline__ void mfma_fp8_first(f32x4& c, v8i a, v8i b, int scale) {
    asm volatile("v_mfma_scale_f32_16x16x128_f8f6f4 %0, %1, %2, 0, %3, %3 op_sel_hi:[0,0,0]" : "+v"(c) : "v"(a), "v"(b), "v"(scale));
}
constexpr int CI_GU = NE * 32 * 128, CI_DN = NE * 32 * 64, MOE_ITEMS64 = CI_GU + CI_DN;
struct ConvJob { const float* wgu; const float* wd; unsigned char* wguT8; unsigned char* wdT8; int j, stride; };
__device__ __forceinline__ void conv_decode(const ConvJob& c, int jc, const char*& src, unsigned char*& dst, int& N) {
    const bool gu = jc < CI_GU; const int jj = gu ? jc : jc - CI_GU;
    const int e = gu ? (jj >> 12) : (jj >> 11), kb = gu ? ((jj >> 7) & 31) : ((jj >> 6) & 31), nb = gu ? (jj & 127) : (jj & 63); N = gu ? 2 * DFF : D;
    src = (const char*)(gu ? c.wgu : c.wd) + ((size_t)e * D * N + (size_t)(64 * kb) * N + 32 * nb) * 4;
    dst = (gu ? c.wguT8 : c.wdT8) + (size_t)e * N * D + (size_t)(32 * nb) * D + 64 * kb;
}
__device__ __forceinline__ void conv_load(f32x4& v, const char* sbase, unsigned voff) { asm volatile("global_load_dwordx4 %0, %1, %2 nt" : "=v"(v) : "v"(voff), "s"(sbase) : "memory"); }
__device__ __forceinline__ void conv_store(unsigned char* dst, int lane, const f32x4& v0, const f32x4& v1, const f32x4& v2, const f32x4& v3, const f32x4& v4, const f32x4& v5, const f32x4& v6, const f32x4& v7) {
    unsigned char* dp = dst + (lane & 7) * (4 * D) + (lane >> 3) * 8;
#pragma unroll
    for (int jn = 0; jn < 4; ++jn) { u32x2 o; o.x = pk4_fp8(v0[jn] * WSCALE, v1[jn] * WSCALE, v2[jn] * WSCALE, v3[jn] * WSCALE); o.y = pk4_fp8(v4[jn] * WSCALE, v5[jn] * WSCALE, v6[jn] * WSCALE, v7[jn] * WSCALE);
        *(u32x2*)(dp + jn * D) = o; }
}
__device__ __forceinline__ void conv_item_sync(const ConvJob& c, int jc, int lane) {
    const char* src; unsigned char* dst; int N; conv_decode(c, jc, src, dst, N);
    const float* sp = (const float*)src + (size_t)(lane >> 3) * 8 * N + (lane & 7) * 4;
    f32x4 v[8];
#pragma unroll
    for (int i = 0; i < 8; ++i) v[i] = *(const f32x4*)(sp + (size_t)i * N);
    conv_store(dst, lane, v[0], v[1], v[2], v[3], v[4], v[5], v[6], v[7]);
}
template <class Epi, class Sched, bool ALIGN_EPI, bool FP8 = false, bool CONV = false, bool MID = false>
__device__ __forceinline__ void gemm_phase(LAS unsigned char* lds, const int KB, const int lda, const int ldb, const Sched& S, const Epi& E, ConvJob* cj = nullptr) {
    const int tid = threadIdx.x, wid = __builtin_amdgcn_readfirstlane(tid >> 6), lane = tid & 63, wr = wid >> 2, wc = wid & 3, fr = lane & 15, fq = lane >> 4;
    const int nt = KB / (BK * 2);
    unsigned voffA, voffB;
    { int R, C; stage_rc(tid * 16, R, C); const int Rb = (R & ~31) + perm32(R & 31); voffA = (unsigned)(R * lda + C * 2); voffB = (unsigned)(Rb * ldb + C * 2); }
    const size_t p1A = (size_t)64 * lda, p1B = (size_t)64 * ldb;
    const size_t kstep = (size_t)(BK * 2);
    const unsigned ldsw = (unsigned)wid * 1024u;
    const int aoff = lds_byte(wr * 64 + fr, fq * 8), boff = lds_byte(wc * 32 + fr, fq * 8);
#define PG8_SA(b, h) (((b) * 2 + (h)) * HTB)
#define PG8_SB(b, h) ((4 + (b) * 2 + (h)) * HTB)
#define PG8_STAGE(bufoff, gbase, voff) do { \
        glds16_s((const char*)(gbase), (voff), (unsigned)(size_t)(lds + (bufoff) + ldsw)); \
        glds16_s((const char*)(gbase) + (&(voff) == &voffA ? p1A : p1B), (voff), (unsigned)(size_t)(lds + (bufoff) + ldsw + 8192)); } while (0)
#define PG8_LDA(dst, b, h) do { _Pragma("unroll") for (int m = 0; m < 4; ++m) _Pragma("unroll") for (int k = 0; k < 2; ++k) dst[m][k] = *(const LAS bf16x8*)(lds + PG8_SA(b, h) + aoff + m * 2048 + k * 1024); } while (0)
#define PG8_LDB(dst, b, h) do { _Pragma("unroll") for (int n = 0; n < 2; ++n) _Pragma("unroll") for (int k = 0; k < 2; ++k) dst[n][k] = *(const LAS bf16x8*)(lds + PG8_SB(b, h) + boff + n * 2048 + k * 1024); } while (0)
#define PG8_MMA(ai, bj, At, Bt, FIRST) do { __builtin_amdgcn_s_setprio(1); \
        if constexpr (FP8) { if (FIRST) { _Pragma("unroll") for (int m = 0; m < 4; ++m) _Pragma("unroll") for (int n = 0; n < 2; ++n) \
            mfma_fp8_first(acc[ai][bj][m][n], cat8(Bt[n][0], Bt[n][1]), cat8(At[m][0], At[m][1]), scale1); } \
          else { _Pragma("unroll") for (int m = 0; m < 4; ++m) _Pragma("unroll") for (int n = 0; n < 2; ++n) \
            mfma_fp8_inplace(acc[ai][bj][m][n], cat8(Bt[n][0], Bt[n][1]), cat8(At[m][0], At[m][1]), scale1); } } \
        else { _Pragma("unroll") for (int m = 0; m < 4; ++m) _Pragma("unroll") for (int n = 0; n < 2; ++n) _Pragma("unroll") for (int k = 0; k < 2; ++k) \
            acc[ai][bj][m][n] = __builtin_amdgcn_mfma_f32_16x16x32_bf16(Bt[n][k], At[m][k], acc[ai][bj][m][n], 0, 0, 0); } \
        __builtin_amdgcn_s_setprio(0); } while (0)
#define PG8_WAIT_V(n) asm volatile("s_waitcnt vmcnt(" #n ")" ::: "memory")
#define PG8_WAIT_L(n) asm volatile("s_waitcnt lgkmcnt(" #n ")" ::: "memory")
#define PG8_BAR __builtin_amdgcn_s_barrier()
#define PG8_SCHED __builtin_amdgcn_sched_barrier(0)
    Unit cur, nxt; int ui = 0;
    if (!S.next(0, cur)) return;
    const int scale1 = 0x7f7f7f7f;
    f32x4 acc[2][2][4][2];
#pragma unroll
    for (int a = 0; a < 2; ++a)
#pragma unroll
        for (int b = 0; b < 2; ++b)
#pragma unroll
            for (int m = 0; m < 4; ++m)
#pragma unroll
                for (int n = 0; n < 2; ++n) acc[a][b][m][n] = (f32x4){0.f, 0.f, 0.f, 0.f};
    bf16x8 At[4][2], B0[2][2], B1[2][2];
    const char* cA0 = cur.a0; const char* cA1 = cur.a1; const char* cB0 = cur.b0; const char* cB1 = cur.b1;
    PG8_STAGE(PG8_SB(0, 0), cB0, voffB); PG8_STAGE(PG8_SB(0, 1), cB1, voffB); PG8_STAGE(PG8_SA(0, 0), cA0, voffA); PG8_STAGE(PG8_SA(0, 1), cA1, voffA);
    if (wr == 1) PG8_BAR;
    PG8_WAIT_V(2); PG8_BAR;
    PG8_STAGE(PG8_SB(1, 0), cB0 + kstep, voffB); PG8_STAGE(PG8_SA(1, 0), cA0 + kstep, voffA); PG8_STAGE(PG8_SB(1, 1), cB1 + kstep, voffB);
    PG8_WAIT_V(6); PG8_BAR;
    for (;;) {
        const bool has_next = S.next(ui + 1, nxt);
        const char* nA0 = has_next ? nxt.a0 : cA0; const char* nA1 = has_next ? nxt.a1 : cA1; const char* nB0 = has_next ? nxt.b0 : cB0; const char* nB1 = has_next ? nxt.b1 : cB1;
        const int tseg = MID ? nt / 2 : nt;
        for (int t0 = 0; t0 < nt; t0 += tseg) {
        if constexpr (MID) { if (t0 != 0) E.mid(acc, cur, wr, wc, fr, fq); }
        for (int t = t0; t < t0 + tseg; t += 2) {
            const bool last = (t == nt - 2), first = FP8 && (t == 0);
            const char* a1_1 = cA1 + (size_t)(t + 1) * kstep;
            const char* a2_0 = last ? nA0 : cA0 + (size_t)(t + 2) * kstep; const char* a2_1 = last ? nA1 : cA1 + (size_t)(t + 2) * kstep;
            const char* b2_0 = last ? nB0 : cB0 + (size_t)(t + 2) * kstep; const char* b2_1 = last ? nB1 : cB1 + (size_t)(t + 2) * kstep;
            const char* a3_0 = a2_0 + kstep; const char* b3_0 = b2_0 + kstep; const char* b3_1 = b2_1 + kstep;
            f32x4 cv0, cv1, cv2, cv3, cv4, cv5, cv6, cv7; unsigned char* cdst = nullptr;
            PG8_LDB(B0, 0, 0); PG8_LDB(B1, 0, 1); PG8_SCHED; PG8_LDA(At, 0, 0);
            if constexpr (CONV) { const int jc = cj->j < MOE_ITEMS64 ? cj->j : MOE_ITEMS64 - 1; cj->j += cj->stride;
                const char* csrc; int cN; conv_decode(*cj, jc, csrc, cdst, cN); const unsigned cvl = (unsigned)((lane >> 3) * (cN * 32) + (lane & 7) * 16); const size_t crow = (size_t)cN * 4;
                conv_load(cv0, csrc, cvl); conv_load(cv1, csrc + crow, cvl); conv_load(cv2, csrc + 2 * crow, cvl); conv_load(cv3, csrc + 3 * crow, cvl);
                conv_load(cv4, csrc + 4 * crow, cvl); conv_load(cv5, csrc + 5 * crow, cvl); conv_load(cv6, csrc + 6 * crow, cvl); conv_load(cv7, csrc + 7 * crow, cvl); }
            PG8_STAGE(PG8_SA(1, 1), a1_1, voffA);
            if constexpr (CONV) PG8_WAIT_V(20); else PG8_WAIT_V(8);
            PG8_WAIT_L(0); PG8_BAR; PG8_MMA(0, 0, At, B0, first); PG8_MMA(0, 1, At, B1, first); PG8_BAR; PG8_SCHED;
            PG8_LDA(At, 0, 1); PG8_STAGE(PG8_SB(0, 0), b2_0, voffB); PG8_STAGE(PG8_SB(0, 1), b2_1, voffB); PG8_STAGE(PG8_SA(0, 0), a2_0, voffA);
            if constexpr (CONV) PG8_WAIT_V(16); else PG8_WAIT_V(8);
            PG8_WAIT_L(0); PG8_BAR; PG8_MMA(1, 0, At, B0, first); PG8_MMA(1, 1, At, B1, first); PG8_BAR; PG8_SCHED;
            PG8_LDB(B0, 1, 0); PG8_LDB(B1, 1, 1); PG8_SCHED; PG8_LDA(At, 1, 0); PG8_STAGE(PG8_SA(0, 1), a2_1, voffA);
            PG8_WAIT_V(8); PG8_WAIT_L(0); PG8_BAR;
            if constexpr (CONV) { asm volatile("" : "+v"(cv0), "+v"(cv1), "+v"(cv2), "+v"(cv3), "+v"(cv4), "+v"(cv5), "+v"(cv6), "+v"(cv7));
                conv_store(cdst, lane, cv0, cv1, cv2, cv3, cv4, cv5, cv6, cv7); }
            PG8_MMA(0, 0, At, B0, false); PG8_MMA(0, 1, At, B1, false); PG8_BAR; PG8_SCHED;
            PG8_LDA(At, 1, 1); PG8_STAGE(PG8_SB(1, 0), b3_0, voffB); PG8_STAGE(PG8_SB(1, 1), b3_1, voffB); PG8_STAGE(PG8_SA(1, 0), a3_0, voffA);
            if constexpr (CONV) PG8_WAIT_V(12); else PG8_WAIT_V(8);
            PG8_WAIT_L(0); PG8_BAR; PG8_MMA(1, 0, At, B0, false); PG8_MMA(1, 1, At, B1, false); PG8_BAR; PG8_SCHED;
        }
        }
        if constexpr (ALIGN_EPI) { if (wr == 0) PG8_BAR; }
        if constexpr (FP8) asm volatile("s_nop 15\n\ts_nop 15" ::: "memory");
        E(acc, cur, wr, wc, fr, fq);
        if (!has_next) break;
        if constexpr (!FP8)
#pragma unroll
        for (int a = 0; a < 2; ++a)
#pragma unroll
            for (int b = 0; b < 2; ++b)
#pragma unroll
                for (int m = 0; m < 4; ++m)
#pragma unroll
                    for (int n = 0; n < 2; ++n) acc[a][b][m][n] = (f32x4){0.f, 0.f, 0.f, 0.f};
        cur = nxt; cA0 = nA0; cA1 = nA1; cB0 = nB0; cB1 = nB1; ++ui;
        if constexpr (ALIGN_EPI) { if (wr == 1) PG8_BAR; }
    }
    PG8_WAIT_V(0);
    if constexpr (!ALIGN_EPI) { if (wr == 0) PG8_BAR; }
    PG8_BAR;
#undef PG8_SA
#undef PG8_SB
#undef PG8_STAGE
#undef PG8_LDA
#undef PG8_LDB
#undef PG8_MMA
#undef PG8_WAIT_V
#undef PG8_WAIT_L
#undef PG8_BAR
#undef PG8_SCHED
}

struct DenseOrder {
    const char* A; const char* Bt; int lda2, ldb2;
    int nM, nN, nwg, G, c, extra, xlo, colbase = 0;
    __device__ void init(const void* A_, const void* Bt_, int lda, int ldb, int M, int N, int G_, int c_, int extra_ = 0, int xlo_ = 0) {
        A = (const char*)A_; Bt = (const char*)Bt_; lda2 = lda * 2; ldb2 = ldb * 2; nM = M / BM; nN = N / BM; nwg = nM * nN; G = G_; c = c_; extra = extra_; xlo = xlo_; }
    __device__ __forceinline__ bool next(int i, Unit& u) const {
        const int L = i * G + c; int pm, pn;
        if (L >= nwg + extra) return false;
        if (L >= nwg) { pm = nM; pn = xlo + (L - nwg); }
        else { const int wgid = xcd_remap(L, nwg); const int nig = WGM * nN, gid = wgid / nig, fm = gid * WGM, gsz = (nM - fm) < WGM ? (nM - fm) : WGM;
            pm = fm + ((wgid % nig) % gsz); pn = (wgid % nig) / gsz; }
        u.a0 = A + (size_t)pm * BM * lda2; u.a1 = u.a0 + (size_t)HALF * lda2; u.b0 = Bt + (size_t)pn * BM * ldb2; u.b1 = u.b0 + (size_t)HALF * ldb2;
        u.row0 = pm * BM; u.col0 = colbase + pn * BM; u.e = 0; return true;
    }
};
struct MoeOrder {
    const char* A; const char* Bt; int npn, G, c, nU; size_t estrideB; int up_off;
    int nrt_l, incl_l;
    __device__ __forceinline__ void init(const void* A_, const void* Bt_, unsigned* ctl, int npn_, size_t estrideB_, int up_off_, int G_, int c_) {
        A = (const char*)A_; Bt = (const char*)Bt_; npn = npn_; estrideB = estrideB_; up_off = up_off_; G = G_; c = c_;
        const int lane = threadIdx.x & 63;
        const int cnt = (lane < NE) ? (int)__hip_atomic_load(ctl + CW_CNT + 64 * lane, __ATOMIC_RELAXED, __HIP_MEMORY_SCOPE_AGENT) : 0;
        nrt_l = (cnt + 255) >> 8; int p = nrt_l;
#pragma unroll
        for (int o = 1; o < 32; o <<= 1) { const int t = __shfl_up(p, o); if (lane >= o) p += t; }
        incl_l = p; nU = __builtin_amdgcn_readlane(p, 31) * npn; }
    __device__ __forceinline__ bool next(int i, Unit& u) const {
        const int L = i * G + c; if (L >= nU) return false;
        const int idx = xcd_remap(L, nU), q = idx / npn, lane = threadIdx.x & 63;
        const int e = __builtin_amdgcn_readfirstlane(__builtin_popcountll(__ballot(lane < NE && incl_l <= q)));
        const int nrt = __builtin_amdgcn_readlane(nrt_l, e), pe = __builtin_amdgcn_readlane(incl_l, e) - nrt;
        const int rem = idx - pe * npn, pn = rem / nrt, rt = rem - pn * nrt;
        u.row0 = e * ECAP + rt * BM; u.e = e;
        u.a0 = A + (size_t)u.row0 * D; u.a1 = u.a0 + (size_t)HALF * D;
        const char* be = Bt + (size_t)e * estrideB;
        if (up_off) { u.col0 = pn * HALF; u.b0 = be + (size_t)(pn * HALF) * D; u.b1 = be + (size_t)(up_off + pn * HALF) * D; }
        else { u.col0 = pn * BM; u.b0 = be + (size_t)(pn * BM) * D; u.b1 = u.b0 + (size_t)HALF * D; }
        return true;
    }
};

#define EPI_ROWS() _Pragma("unroll") for (int ai = 0; ai < 2; ++ai) _Pragma("unroll") for (int m = 0; m < 4; ++m)
struct EpiProj {
    bf16_t* proj; float sc;
    __device__ __forceinline__ void operator()(const f32x4 (&acc)[2][2][4][2], const Unit& u, int wr, int wc, int fr, int fq) const {
        const int r0 = u.row0 + wr * 64 + fr, c0 = u.col0 + wc * 32 + 8 * fq;
        const bool rope = (u.col0 < OFF_V) && ((wc & 1) == 0);
        const bool gate = (u.col0 >= OFF_GA);
        EPI_ROWS() { const int r = r0 + ai * HALF + m * 16; bf16_t* rowp = proj + (size_t)r * IN_DIM + c0;
            float cs[8], sn[8];
            if (rope) { const float ps = (float)((r < T) ? (NMETA + (r & (SEQ - 1))) : (r - T));
#pragma unroll
                for (int i = 0; i < 8; ++i) { float rev = ps * c_invrev[i]; rev -= floorf(rev); sn[i] = __builtin_amdgcn_sinf(rev); cs[i] = __builtin_amdgcn_cosf(rev); } }
#pragma unroll
            for (int bj = 0; bj < 2; ++bj) { f32x4 v0 = acc[ai][bj][m][0], v1 = acc[ai][bj][m][1];
                if (sc != 1.0f) { v0 = v0 * (f32x4){sc, sc, sc, sc}; v1 = v1 * (f32x4){sc, sc, sc, sc}; }
                if (rope) {
#pragma unroll
                    for (int i = 0; i < 4; ++i) { const float o0 = __shfl_xor(v0[i], 16), o1 = __shfl_xor(v1[i], 16);
                        const float a0 = (fq == 0) ? v0[i] * cs[i] - o0 * sn[i] : v0[i] * cs[i] + o0 * sn[i], a1 = (fq == 0) ? v1[i] * cs[4 + i] - o1 * sn[4 + i] : v1[i] * cs[4 + i] + o1 * sn[4 + i];
                        if (fq < 2) { v0[i] = a0; v1[i] = a1; } } }
                if (gate) {
#pragma unroll
                    for (int i = 0; i < 4; ++i) { v0[i] = sigmoidf_(fmaxf(v0[i], -60.f)); v1[i] = sigmoidf_(fmaxf(v1[i], -60.f)); } }
                u32x4 w; w.x = cvt_pk_bf16(v0[0], v0[1]); w.y = cvt_pk_bf16(v0[2], v0[3]); w.z = cvt_pk_bf16(v1[0], v1[1]); w.w = cvt_pk_bf16(v1[2], v1[3]);
                *(u32x4*)(rowp + bj * HALF) = w; } }
    }
};
struct EpiM1 {
    const bf16_t* proj; float* m1;
    __device__ __forceinline__ void operator()(const f32x4 (&acc)[2][2][4][2], const Unit& u, int wr, int wc, int fr, int fq) const {
        const int r0 = u.row0 + wr * 64 + fr, c0 = u.col0 + wc * 32 + 8 * fq;
        EPI_ROWS() { const int r = r0 + ai * HALF + m * 16;
#pragma unroll
            for (int bj = 0; bj < 2; ++bj) { const int c = c0 + bj * HALF; const u32x4 g = *(const u32x4*)(proj + (size_t)r * IN_DIM + OFF_GA + c);
                const f32x4 v0 = acc[ai][bj][m][0], v1 = acc[ai][bj][m][1]; f32x4 o0, o1;
                o0[0] = sigmoidf_(bflo(g.x)) * v0[0]; o0[1] = sigmoidf_(bfhi(g.x)) * v0[1]; o0[2] = sigmoidf_(bflo(g.y)) * v0[2]; o0[3] = sigmoidf_(bfhi(g.y)) * v0[3];
                o1[0] = sigmoidf_(bflo(g.z)) * v1[0]; o1[1] = sigmoidf_(bfhi(g.z)) * v1[1]; o1[2] = sigmoidf_(bflo(g.w)) * v1[2]; o1[3] = sigmoidf_(bfhi(g.w)) * v1[3];
                float* op = m1 + (size_t)r * D + c; *(f32x4*)op = o0; *(f32x4*)(op + 4) = o1; } }
    }
};
struct EpiMerged {
    const bf16_t* proj; const float* m1; bf16_t* merged;
    __device__ __forceinline__ void operator()(const f32x4 (&acc)[2][2][4][2], const Unit& u, int wr, int wc, int fr, int fq) const {
        const int r0 = u.row0 + wr * 64 + fr, c0 = u.col0 + wc * 32 + 8 * fq;
        EPI_ROWS() { const int r = r0 + ai * HALF + m * 16;
#pragma unroll
            for (int bj = 0; bj < 2; ++bj) { const int c = c0 + bj * HALF; const u32x4 g = *(const u32x4*)(proj + (size_t)r * IN_DIM + OFF_GC + c);
                const float* mp = m1 + (size_t)r * D + c; const f32x4 p0 = *(const f32x4*)mp, p1 = *(const f32x4*)(mp + 4);
                const f32x4 v0 = acc[ai][bj][m][0], v1 = acc[ai][bj][m][1]; u32x4 w;
                w.x = cvt_pk_bf16(p0[0] + sigmoidf_(bflo(g.x)) * v0[0], p0[1] + sigmoidf_(bfhi(g.x)) * v0[1]); w.y = cvt_pk_bf16(p0[2] + sigmoidf_(bflo(g.y)) * v0[2], p0[3] + sigmoidf_(bfhi(g.y)) * v0[3]);
                w.z = cvt_pk_bf16(p1[0] + sigmoidf_(bflo(g.z)) * v1[0], p1[1] + sigmoidf_(bfhi(g.z)) * v1[1]); w.w = cvt_pk_bf16(p1[2] + sigmoidf_(bflo(g.w)) * v1[2], p1[3] + sigmoidf_(bfhi(g.w)) * v1[3]);
                *(u32x4*)(merged + (size_t)r * D + c) = w; } }
    }
};
struct EpiGated {
    const bf16_t* proj; bf16_t* merged;
    __device__ __forceinline__ void mid(f32x4 (&acc)[2][2][4][2], const Unit& u, int wr, int wc, int fr, int fq) const {
        asm volatile("" : "+v"(fr), "+v"(fq));
        const int r0 = u.row0 + wr * 64 + fr, c0 = u.col0 + wc * 32 + 8 * fq;
        constexpr int MB = 4;
#pragma unroll
        for (int ai = 0; ai < 2; ++ai)
#pragma unroll
            for (int m0 = 0; m0 < 4; m0 += MB) {
                u32x4 ga[MB][2], gc[MB][2];
#pragma unroll
                for (int mm = 0; mm < MB; ++mm)
#pragma unroll
                    for (int bj = 0; bj < 2; ++bj) { const bf16_t* gp = proj + (size_t)(r0 + ai * HALF + (m0 + mm) * 16) * IN_DIM + c0 + bj * HALF; ga[mm][bj] = *(const u32x4*)(gp + OFF_GA); gc[mm][bj] = *(const u32x4*)(gp + OFF_GC); }
#pragma unroll
                for (int mm = 0; mm < MB; ++mm)
#pragma unroll
                    for (int bj = 0; bj < 2; ++bj)
#pragma unroll
                        for (int q = 0; q < 4; ++q) {
                            const float fl = bflo(ga[mm][bj][q]) * __builtin_amdgcn_rcpf(bflo(gc[mm][bj][q])), fh = bfhi(ga[mm][bj][q]) * __builtin_amdgcn_rcpf(bfhi(gc[mm][bj][q]));
                            acc[ai][bj][m0 + mm][q >> 1][(q & 1) * 2] *= fl; acc[ai][bj][m0 + mm][q >> 1][(q & 1) * 2 + 1] *= fh; }
                asm volatile("" ::: "memory"); }
    }
    __device__ __forceinline__ void operator()(const f32x4 (&acc)[2][2][4][2], const Unit& u, int wr, int wc, int fr, int fq) const {
        const int r0 = u.row0 + wr * 64 + fr, c0 = u.col0 + wc * 32 + 8 * fq;
#pragma unroll
        for (int ai = 0; ai < 2; ++ai) {
            u32x4 g[4][2];
#pragma unroll
            for (int m = 0; m < 4; ++m)
#pragma unroll
                for (int bj = 0; bj < 2; ++bj) g[m][bj] = *(const u32x4*)(proj + (size_t)(r0 + ai * HALF + m * 16) * IN_DIM + OFF_GC + c0 + bj * HALF);
#pragma unroll
            for (int m = 0; m < 4; ++m)
#pragma unroll
                for (int bj = 0; bj < 2; ++bj) { const u32x4 gg = g[m][bj]; const f32x4 v0 = acc[ai][bj][m][0], v1 = acc[ai][bj][m][1]; u32x4 w;
                    if constexpr (P5_FP8) { u32x2 w8;
                        w8.x = pk4_fp8(bflo(gg.x) * v0[0] * MSCALE, bfhi(gg.x) * v0[1] * MSCALE, bflo(gg.y) * v0[2] * MSCALE, bfhi(gg.y) * v0[3] * MSCALE);
                        w8.y = pk4_fp8(bflo(gg.z) * v1[0] * MSCALE, bfhi(gg.z) * v1[1] * MSCALE, bflo(gg.w) * v1[2] * MSCALE, bfhi(gg.w) * v1[3] * MSCALE);
                        *(u32x2*)((unsigned char*)merged + (size_t)(r0 + ai * HALF + m * 16) * D + c0 + bj * HALF) = w8; }
                    else {
                    w.x = cvt_pk_bf16(bflo(gg.x) * v0[0], bfhi(gg.x) * v0[1]); w.y = cvt_pk_bf16(bflo(gg.y) * v0[2], bfhi(gg.y) * v0[3]);
                    w.z = cvt_pk_bf16(bflo(gg.z) * v1[0], bfhi(gg.z) * v1[1]); w.w = cvt_pk_bf16(bflo(gg.w) * v1[2], bfhi(gg.w) * v1[3]);
                    *(u32x4*)(merged + (size_t)(r0 + ai * HALF + m * 16) * D + c0 + bj * HALF) = w; } }
            asm volatile("" ::: "memory"); }
    }
};
struct EpiH1 {
    const float* x; float* h1; float sc;
    __device__ __forceinline__ void operator()(const f32x4 (&acc)[2][2][4][2], const Unit& u, int wr, int wc, int fr, int fq) const {
        const int r0 = u.row0 + wr * 64 + fr, c0 = u.col0 + wc * 32 + 8 * fq;
#pragma unroll
        for (int ai = 0; ai < 2; ++ai) {
            f32x4 xv[4][2][2];
#pragma unroll
            for (int m = 0; m < 4; ++m)
#pragma unroll
                for (int bj = 0; bj < 2; ++bj) { const size_t o = (size_t)(r0 + ai * HALF + m * 16) * D + c0 + bj * HALF; xv[m][bj][0] = *(const f32x4*)(x + o); xv[m][bj][1] = *(const f32x4*)(x + o + 4); }
#pragma unroll
            for (int m = 0; m < 4; ++m)
#pragma unroll
                for (int bj = 0; bj < 2; ++bj) { const size_t o = (size_t)(r0 + ai * HALF + m * 16) * D + c0 + bj * HALF;
                    *(f32x4*)(h1 + o) = xv[m][bj][0] + acc[ai][bj][m][0] * (f32x4){sc, sc, sc, sc}; *(f32x4*)(h1 + o + 4) = xv[m][bj][1] + acc[ai][bj][m][1] * (f32x4){sc, sc, sc, sc}; }
            asm volatile("" ::: "memory"); }
    }
};
struct EpiAct {
    const float* bgu; unsigned char* act;
    __device__ __forceinline__ void operator()(const f32x4 (&acc)[2][2][4][2], const Unit& u, int wr, int wc, int fr, int fq) const {
        const int r0 = u.row0 + wr * 64 + fr, c = u.col0 + wc * 32 + 8 * fq;
        const float* bp = bgu + (size_t)u.e * (2 * DFF) + c;
        const f32x4 bg0 = *(const f32x4*)bp, bg1 = *(const f32x4*)(bp + 4), bu0 = *(const f32x4*)(bp + DFF), bu1 = *(const f32x4*)(bp + DFF + 4);
        const f32x2 ws2 = (f32x2){WSCALE_INV, WSCALE_INV}, one2 = (f32x2){1.0f, 1.0f}, k2 = (f32x2){-1.702f * 1.4426950408889634f, -1.702f * 1.4426950408889634f};
        EPI_ROWS() { const int r = r0 + ai * HALF + m * 16; f32x2 o[4];
#pragma unroll
            for (int n = 0; n < 2; ++n)
#pragma unroll
                for (int h = 0; h < 2; ++h) { const f32x4 ag = acc[ai][0][m][n], au = acc[ai][1][m][n], bgv = n ? bg1 : bg0, buv = n ? bu1 : bu0;
                    f32x2 g = (f32x2){ag[2 * h], ag[2 * h + 1]} * ws2 + (f32x2){bgv[2 * h], bgv[2 * h + 1]}, up = (f32x2){au[2 * h], au[2 * h + 1]} * ws2 + (f32x2){buv[2 * h], buv[2 * h + 1]};
                    g.x = fminf(g.x, 7.0f); g.y = fminf(g.y, 7.0f); up.x = fminf(fmaxf(up.x, -7.0f), 7.0f); up.y = fminf(fmaxf(up.y, -7.0f), 7.0f);
                    const f32x2 t = g * k2; f32x2 d = (f32x2){__builtin_amdgcn_exp2f(t.x), __builtin_amdgcn_exp2f(t.y)} + one2;
                    const f32x2 rc = (f32x2){__builtin_amdgcn_rcpf(d.x), __builtin_amdgcn_rcpf(d.y)};
                    o[n * 2 + h] = (up + one2) * g * rc; }
            u32x2 w; w.x = pk4_fp8(o[0].x, o[0].y, o[1].x, o[1].y); w.y = pk4_fp8(o[2].x, o[2].y, o[3].x, o[3].y);
            *(u32x2*)(act + (size_t)r * DFF + c) = w; }
    }
};
struct EpiY {
    const float* bd; const float* gatel; unsigned char* yr;
    __device__ __forceinline__ void operator()(const f32x4 (&acc)[2][2][4][2], const Unit& u, int wr, int wc, int fr, int fq) const {
        const int r0 = u.row0 + wr * 64 + fr, c0 = u.col0 + wc * 32 + 8 * fq;
        f32x4 bv[2][2];
#pragma unroll
        for (int bj = 0; bj < 2; ++bj) { const float* bp = bd + (size_t)u.e * D + c0 + bj * HALF; bv[bj][0] = *(const f32x4*)bp; bv[bj][1] = *(const f32x4*)(bp + 4); }
        EPI_ROWS() { const int r = r0 + ai * HALF + m * 16; const float g = gatel[r] * YSCALE;
#pragma unroll
            for (int bj = 0; bj < 2; ++bj) { const f32x4 v0 = (acc[ai][bj][m][0] * (f32x4){WSCALE_INV, WSCALE_INV, WSCALE_INV, WSCALE_INV} + bv[bj][0]) * (f32x4){g, g, g, g}, v1 = (acc[ai][bj][m][1] * (f32x4){WSCALE_INV, WSCALE_INV, WSCALE_INV, WSCALE_INV} + bv[bj][1]) * (f32x4){g, g, g, g}; u32x2 w;
                w.x = pk4_fp8(v0[0], v0[1], v0[2], v0[3]); w.y = pk4_fp8(v1[0], v1[1], v1[2], v1[3]);
                *(u32x2*)(yr + (size_t)r * D + c0 + bj * HALF) = w; } }
    }
};
}

__device__ __forceinline__ void p0_transpose_item(const float* W, int N, bf16_t* WT, int ldt, int koff, LAS float* scr, int kb, int nb, int lane) {
    const int k0 = 64 * kb, n0 = 32 * nb;
    float v[32];
    const float* wp = W + (size_t)(k0 + (lane >> 5)) * N + n0 + (lane & 31);
#pragma unroll
    for (int i = 0; i < 32; ++i) v[i] = __builtin_nontemporal_load(wp + (size_t)(2 * i) * N);
#pragma unroll
    for (int i = 0; i < 32; ++i) scr[(2 * i + (lane >> 5)) * 33 + (lane & 31)] = v[i];
    asm volatile("s_waitcnt lgkmcnt(0)" ::: "memory");
    const int c = lane & 7;
#pragma unroll
    for (int j = 0; j < 4; ++j) { const int n = (lane >> 3) + 8 * j; const LAS float* s = scr + (8 * c) * 33 + n;
        u32x4 o; o.x = pk2(s[0 * 33], s[1 * 33]); o.y = pk2(s[2 * 33], s[3 * 33]); o.z = pk2(s[4 * 33], s[5 * 33]); o.w = pk2(s[6 * 33], s[7 * 33]);
        *(u32x4*)(WT + (size_t)(n0 + n) * ldt + koff + k0 + 8 * c) = o; }
    asm volatile("s_waitcnt lgkmcnt(0)" ::: "memory");
}


typedef float f32x16 __attribute__((ext_vector_type(16)));
constexpr int AT_KP = 144, AT_VP = 840, AT_V_OFF = 416 * AT_KP;
__device__ __forceinline__ float xhalf_max(float v) {
    const unsigned u = __builtin_bit_cast(unsigned, v); const auto r = __builtin_amdgcn_permlane32_swap(u, u, false, false);
    return fmaxf(__builtin_bit_cast(float, (unsigned)r[0]), __builtin_bit_cast(float, (unsigned)r[1]));
}
__device__ __forceinline__ void attn_unit(LAS unsigned char* lds, const bf16_t* proj, const float* sink, bf16_t* ac, int b, int nb, int hk) {
    const int tid = threadIdx.x, wave = __builtin_amdgcn_readfirstlane(tid >> 6), lane = tid & 63, r31 = lane & 31, h = lane >> 5;
    const int s0 = 128 * nb - 128;
    const int head = hk * 4 + (wave >> 1), qhalf = wave & 1, ql0 = 64 * qhalf;
    const size_t qrow0 = (size_t)b * SEQ + 128 * nb + ql0 + r31;
    bf16x8 qf0[4], qf1[4];
#pragma unroll
    for (int ks = 0; ks < 4; ++ks) { qf0[ks] = *(const bf16x8*)(proj + qrow0 * IN_DIM + OFF_Q + head * 64 + 16 * ks + 8 * h); qf1[ks] = *(const bf16x8*)(proj + (qrow0 + 32) * IN_DIM + OFF_Q + head * 64 + 16 * ks + 8 * h); }
    {
        u32x4 kvr[7], vvr[7];
#pragma unroll
        for (int it = 0; it < 7; ++it) { const int p = tid + it * NT, slot = p >> 3, ch = p & 7; int krow = 0; bool valid = (p < 416 * 8);
            if (slot < NMETA) krow = T + slot;
            else if (slot < 32) valid = false;
            else { const int sk = s0 + slot - 32; valid = valid && (sk >= 0 && sk < SEQ); krow = b * SEQ + sk; }
            kvr[it] = (u32x4){0u, 0u, 0u, 0u}; vvr[it] = (u32x4){0u, 0u, 0u, 0u};
            if (valid) { const bf16_t* rp = proj + (size_t)krow * IN_DIM + hk * 64 + 8 * ch; kvr[it] = *(const u32x4*)(rp + OFF_K); vvr[it] = *(const u32x4*)(rp + OFF_V); } }
#pragma unroll
        for (int it = 0; it < 7; ++it) { const int p = tid + it * NT, slot = p >> 3, ch = p & 7;
            if (p < 416 * 8) { const u32x4 kv = kvr[it], vv = vvr[it];
                *(LAS u32x4*)(lds + slot * AT_KP + ch * 16) = kv;
                LAS bf16_t* vt = (LAS bf16_t*)(lds + AT_V_OFF + (8 * ch) * AT_VP + slot * 2);
                vt[0 * (AT_VP / 2)] = (bf16_t)(vv.x & 0xffffu); vt[1 * (AT_VP / 2)] = (bf16_t)(vv.x >> 16); vt[2 * (AT_VP / 2)] = (bf16_t)(vv.y & 0xffffu); vt[3 * (AT_VP / 2)] = (bf16_t)(vv.y >> 16);
                vt[4 * (AT_VP / 2)] = (bf16_t)(vv.z & 0xffffu); vt[5 * (AT_VP / 2)] = (bf16_t)(vv.z >> 16); vt[6 * (AT_VP / 2)] = (bf16_t)(vv.w & 0xffffu); vt[7 * (AT_VP / 2)] = (bf16_t)(vv.w >> 16); } }
    }
    __syncthreads();
    const float SC = 0.125f * 1.4426950408889634f, sink2 = sink[head] * 1.4426950408889634f;
    unsigned m_lo = 0u, m_hi = 0u;
#pragma unroll
    for (int rg = 0; rg < 16; ++rg) { const int kr = (rg & 3) + 8 * (rg >> 2) + 4 * h; m_lo |= (kr >= r31) ? (1u << rg) : 0u; m_hi |= (kr <= r31) ? (1u << rg) : 0u; }
    f32x16 Oa0, Oa1, Ob0, Ob1;
#pragma unroll
    for (int i = 0; i < 16; ++i) { Oa0[i] = 0.f; Oa1[i] = 0.f; Ob0[i] = 0.f; Ob1[i] = 0.f; }
    float ma = sink2, la = (h == 0) ? 1.0f : 0.0f, mb = sink2, lb = la;
    for (int ti = 0; ti < 11; ++ti) {
        int slot = 0, mta = 3, mtb = 3;
        if (ti > 0) { const int i = ti - 1, k0 = 128 * nb + ql0 - 128 + 32 * i; if (k0 < 0 || k0 >= SEQ) continue; slot = 32 + ql0 + 32 * i;
            mta = (i == 0) ? 1 : (i == 8) ? 2 : (i == 9) ? 4 : 0; mtb = (i == 0) ? 4 : (i == 1) ? 1 : (i == 9) ? 2 : 0; }
        f32x16 Sa, Sb;
        { const f32x16 Z = (f32x16){0.f, 0.f, 0.f, 0.f, 0.f, 0.f, 0.f, 0.f, 0.f, 0.f, 0.f, 0.f, 0.f, 0.f, 0.f, 0.f};
          const bf16x8 kf = *(const LAS bf16x8*)(lds + (slot + r31) * AT_KP + (8 * h) * 2);
          Sa = __builtin_amdgcn_mfma_f32_32x32x16_bf16(kf, qf0[0], Z, 0, 0, 0); Sb = __builtin_amdgcn_mfma_f32_32x32x16_bf16(kf, qf1[0], Z, 0, 0, 0); }
#pragma unroll
        for (int ks = 1; ks < 4; ++ks) { const bf16x8 kf = *(const LAS bf16x8*)(lds + (slot + r31) * AT_KP + (16 * ks + 8 * h) * 2);
            Sa = __builtin_amdgcn_mfma_f32_32x32x16_bf16(kf, qf0[ks], Sa, 0, 0, 0); Sb = __builtin_amdgcn_mfma_f32_32x32x16_bf16(kf, qf1[ks], Sb, 0, 0, 0); }
        float pa[16], pb[16];
        if (mta != 0) { const unsigned msk = (mta == 1) ? m_lo : (mta == 2) ? m_hi : (mta == 3) ? 0x00ffu : 0u;
#pragma unroll
            for (int rg = 0; rg < 16; ++rg) Sa[rg] = (msk & (1u << rg)) ? Sa[rg] : -1.0e30f; }
        if (mtb != 0) { const unsigned msk = (mtb == 1) ? m_lo : (mtb == 2) ? m_hi : (mtb == 3) ? 0x00ffu : 0u;
#pragma unroll
            for (int rg = 0; rg < 16; ++rg) Sb[rg] = (msk & (1u << rg)) ? Sb[rg] : -1.0e30f; }
        float mxa = Sa[0], mxb = Sb[0];
#pragma unroll
        for (int rg = 1; rg < 16; ++rg) { mxa = fmaxf(mxa, Sa[rg]); mxb = fmaxf(mxb, Sb[rg]); }
        mxa = xhalf_max(mxa); mxb = xhalf_max(mxb);
        const float ca = mxa * SC, cb2 = mxb * SC;
        const float mna = (ca > ma + 8.0f) ? ca : ma, ala = __builtin_amdgcn_exp2f(ma - mna), mnb = (cb2 > mb + 8.0f) ? cb2 : mb, alb = __builtin_amdgcn_exp2f(mb - mnb);
        float psa = 0.f, psb = 0.f;
#pragma unroll
        for (int rg = 0; rg < 16; ++rg) { pa[rg] = __builtin_amdgcn_exp2f(__builtin_fmaf(Sa[rg], SC, -mna)); psa += pa[rg]; pb[rg] = __builtin_amdgcn_exp2f(__builtin_fmaf(Sb[rg], SC, -mnb)); psb += pb[rg]; }
        la = la * ala + psa; ma = mna; lb = lb * alb + psb; mb = mnb;
        if (__any(ala != 1.0f)) {
#pragma unroll
            for (int i = 0; i < 16; ++i) { Oa0[i] *= ala; Oa1[i] *= ala; } }
        if (__any(alb != 1.0f)) {
#pragma unroll
            for (int i = 0; i < 16; ++i) { Ob0[i] *= alb; Ob1[i] *= alb; } }
#pragma unroll
        for (int sx = 0; sx < 2; ++sx) {
            u32x4 pw; pw.x = pg8::cvt_pk_bf16(pa[8 * sx + 0], pa[8 * sx + 1]); pw.y = pg8::cvt_pk_bf16(pa[8 * sx + 2], pa[8 * sx + 3]); pw.z = pg8::cvt_pk_bf16(pa[8 * sx + 4], pa[8 * sx + 5]); pw.w = pg8::cvt_pk_bf16(pa[8 * sx + 6], pa[8 * sx + 7]);
            const bf16x8 pba = __builtin_bit_cast(bf16x8, pw);
            pw.x = pg8::cvt_pk_bf16(pb[8 * sx + 0], pb[8 * sx + 1]); pw.y = pg8::cvt_pk_bf16(pb[8 * sx + 2], pb[8 * sx + 3]); pw.z = pg8::cvt_pk_bf16(pb[8 * sx + 4], pb[8 * sx + 5]); pw.w = pg8::cvt_pk_bf16(pb[8 * sx + 6], pb[8 * sx + 7]);
            const bf16x8 pbb = __builtin_bit_cast(bf16x8, pw);
#pragma unroll
            for (int dt = 0; dt < 2; ++dt) {
                const LAS unsigned char* vp = lds + AT_V_OFF + (32 * dt + r31) * AT_VP + (slot + 16 * sx + 4 * h) * 2;
                const u32x2 lo = *(const LAS u32x2*)vp, hi = *(const LAS u32x2*)(vp + 16);
                u32x4 vw; vw.x = lo.x; vw.y = lo.y; vw.z = hi.x; vw.w = hi.y;
                const bf16x8 vf = __builtin_bit_cast(bf16x8, vw);
                if (dt == 0) { Oa0 = __builtin_amdgcn_mfma_f32_32x32x16_bf16(vf, pba, Oa0, 0, 0, 0); Ob0 = __builtin_amdgcn_mfma_f32_32x32x16_bf16(vf, pbb, Ob0, 0, 0, 0); }
                else { Oa1 = __builtin_amdgcn_mfma_f32_32x32x16_bf16(vf, pba, Oa1, 0, 0, 0); Ob1 = __builtin_amdgcn_mfma_f32_32x32x16_bf16(vf, pbb, Ob1, 0, 0, 0); }
            }
        }
    }
#pragma unroll
    for (int qs = 0; qs < 2; ++qs) {
        float l = qs ? lb : la; l += __shfl_xor(l, 32);
        const float inv = 1.0f / l;
        bf16_t* op = ac + (qrow0 + 32 * qs) * D + head * 64 + 4 * h;
#pragma unroll
        for (int rg4 = 0; rg4 < 4; ++rg4) {
            u32x2 w0, w1;
            if (qs == 0) { w0.x = pg8::cvt_pk_bf16(Oa0[4 * rg4 + 0] * inv, Oa0[4 * rg4 + 1] * inv); w0.y = pg8::cvt_pk_bf16(Oa0[4 * rg4 + 2] * inv, Oa0[4 * rg4 + 3] * inv);
                w1.x = pg8::cvt_pk_bf16(Oa1[4 * rg4 + 0] * inv, Oa1[4 * rg4 + 1] * inv); w1.y = pg8::cvt_pk_bf16(Oa1[4 * rg4 + 2] * inv, Oa1[4 * rg4 + 3] * inv); }
            else { w0.x = pg8::cvt_pk_bf16(Ob0[4 * rg4 + 0] * inv, Ob0[4 * rg4 + 1] * inv); w0.y = pg8::cvt_pk_bf16(Ob0[4 * rg4 + 2] * inv, Ob0[4 * rg4 + 3] * inv);
                w1.x = pg8::cvt_pk_bf16(Ob1[4 * rg4 + 0] * inv, Ob1[4 * rg4 + 1] * inv); w1.y = pg8::cvt_pk_bf16(Ob1[4 * rg4 + 2] * inv, Ob1[4 * rg4 + 3] * inv); }
            *(u32x2*)(op + 8 * rg4) = w0; *(u32x2*)(op + 32 + 8 * rg4) = w1;
        }
    }
}


__device__ __forceinline__ void conv128_load(f32x4 (&v)[16], const float* W, int N, int kb, int nb, int lane) {
    const float* wp = W + (size_t)(128 * kb + 16 * (lane >> 3)) * N + 32 * nb + 4 * (lane & 7);
#pragma unroll
    for (int i = 0; i < 16; ++i) v[i] = __builtin_nontemporal_load((const f32x4*)(wp + (size_t)i * N));
}
__device__ __forceinline__ void conv128_store(const f32x4 (&v)[16], unsigned char* WT, int ldt, int kb, int nb, int lane) {
    unsigned char* dp = WT + (size_t)(32 * nb + 4 * (lane & 7)) * ldt + 128 * kb + 16 * (lane >> 3);
#pragma unroll
    for (int j = 0; j < 4; ++j) { u32x4 o;
        o.x = pg8::pk4_fp8(v[0][j] * WSCALE, v[1][j] * WSCALE, v[2][j] * WSCALE, v[3][j] * WSCALE); o.y = pg8::pk4_fp8(v[4][j] * WSCALE, v[5][j] * WSCALE, v[6][j] * WSCALE, v[7][j] * WSCALE);
        o.z = pg8::pk4_fp8(v[8][j] * WSCALE, v[9][j] * WSCALE, v[10][j] * WSCALE, v[11][j] * WSCALE); o.w = pg8::pk4_fp8(v[12][j] * WSCALE, v[13][j] * WSCALE, v[14][j] * WSCALE, v[15][j] * WSCALE);
        __builtin_nontemporal_store(o, (u32x4*)(dp + (size_t)j * ldt)); }
}
__device__ __forceinline__ void p0_convert_item_fp8(const float* W, int N, unsigned char* WT, int ldt, int kb, int nb, int lane) {
    f32x4 v[16]; conv128_load(v, W, N, kb, nb, lane); conv128_store(v, WT, ldt, kb, nb, lane);
}
constexpr int I_GU = 16 * 128, I_DN = 16 * 64, MOE_ITEMS = NE * (I_GU + I_DN);
constexpr int MOE_ITEMS_P6 = 0;
constexpr int CONV_GG = 120;
__device__ __forceinline__ void moe_convert_item(int j, const float* wgu, const float* wd, unsigned char* wguT8, unsigned char* wdT8, int lane) {
    if (j < NE * I_GU) { const int e = j / I_GU, q = j % I_GU; p0_convert_item_fp8(wgu + (size_t)e * D * 2 * DFF, 2 * DFF, wguT8 + (size_t)e * 2 * DFF * D, D, q / 128, q % 128, lane); }
    else { j -= NE * I_GU; const int e = j / I_DN, q = j % I_DN; p0_convert_item_fp8(wd + (size_t)e * DFF * D, D, wdT8 + (size_t)e * D * DFF, DFF, q / 64, q % 64, lane); }
}
constexpr int MOE_CHUNKS = MOE_ITEMS / 8;
__device__ __forceinline__ void moe_convert_chunk(int chunk, const float* wgu, const float* wd, unsigned char* wguT8, unsigned char* wdT8, int lane) {
    int j = chunk * 8; const float* W; unsigned char* WT; int N, kb, nb0;
    if (j < NE * I_GU) { const int e = j / I_GU, q = j % I_GU; W = wgu + (size_t)e * D * 2 * DFF; WT = wguT8 + (size_t)e * 2 * DFF * D; N = 2 * DFF; kb = q / 128; nb0 = q % 128; }
    else { j -= NE * I_GU; const int e = j / I_DN, q = j % I_DN; W = wd + (size_t)e * DFF * D; WT = wdT8 + (size_t)e * D * DFF; N = D; kb = q / 64; nb0 = q % 64; }
    f32x4 va[16], vb[16];
    conv128_load(va, W, N, kb, nb0, lane); conv128_load(vb, W, N, kb, nb0 + 1, lane);
#pragma unroll
    for (int k = 0; k < 8; k += 2) {
        conv128_store(va, WT, D, kb, nb0 + k, lane); if (k + 2 < 8) conv128_load(va, W, N, kb, nb0 + k + 2, lane);
        conv128_store(vb, WT, D, kb, nb0 + k + 1, lane); if (k + 3 < 8) conv128_load(vb, W, N, kb, nb0 + k + 3, lane);
    }
}
struct Args { const float* in[17]; float* out; unsigned char* ws; };

typedef const __attribute__((address_space(4))) Args* kargs_t;
#define ARGS \
    kargs_t ap_ = (kargs_t)__builtin_amdgcn_kernarg_segment_ptr(); asm volatile("" : "+s"(ap_)); \
    int tid = tid0; asm volatile("" : "+v"(tid)); const int lane = tid & 63; (void)lane;   \
    unsigned char* const ws = ap_->ws; unsigned* const ctl = (unsigned*)(ws + WS_CTL); \
    const float* const x = ap_->in[0]; const float* const meta = ap_->in[1]; const float* const g_mix = ap_->in[2]; const float* const w_in = ap_->in[3]; \
    const float* const conv_w = ap_->in[4]; const float* const sink = ap_->in[5]; const float* const w_ao = ap_->in[6]; const float* const w_co = ap_->in[7]; \
    const float* const w_out = ap_->in[8]; const float* const g_ffn = ap_->in[9]; const float* const rw = ap_->in[10]; const float* const rb = ap_->in[11]; \
    const float* const wgu = ap_->in[12]; const float* const bgu = ap_->in[13]; const float* const wd = ap_->in[14]; const float* const bd = ap_->in[15]; \
    const float* const g_fin = ap_->in[16]; float* const out = ap_->out; \
    bf16_t* const hn = (bf16_t*)(ws + WS_HN); bf16_t* const proj = (bf16_t*)(ws + WS_PROJ); bf16_t* const ac = (bf16_t*)(ws + WS_AC); \
    float* const m1 = (float*)(ws + WS_M1); bf16_t* const merged = (bf16_t*)(ws + WS_MERGED); float* const h1 = (float*)(ws + WS_H1); \
    float* const gatel = (float*)(ws + WS_GATEL); int* const pos = (int*)(ws + WS_POS); \
    unsigned char* const xs8 = ws + WS_XS; unsigned char* const act8 = ws + WS_ACT; unsigned char* const yr = ws + WS_XS; unsigned char* const hn8 = ws + WS_HN8; unsigned char* const winT8 = ws + WS_WIN8; \
    bf16_t* const wrT = (bf16_t*)(ws + WS_WRT); bf16_t* const winT = (bf16_t*)(ws + WS_WIN); bf16_t* const wacT = (bf16_t*)(ws + WS_WAC); bf16_t* const woutT = (bf16_t*)(ws + WS_WOUT); \
    unsigned char* const wguT8 = ws + WS_WGU; unsigned char* const wdT8 = ws + WS_WD; \
    (void)ctl; (void)x; (void)meta; (void)g_mix; (void)w_in; (void)conv_w; (void)sink; (void)w_ao; (void)w_co; (void)w_out; (void)g_ffn; (void)rw; (void)rb; (void)wgu; (void)bgu; (void)wd; (void)bd; (void)g_fin; (void)out; \
    (void)hn; (void)proj; (void)ac; (void)m1; (void)merged; (void)h1; (void)gatel; (void)pos; (void)xs8; (void)act8; (void)yr; (void)hn8; (void)winT8; (void)wrT; (void)winT; (void)wacT; (void)woutT; (void)wguT8; (void)wdT8;
__global__ void __launch_bounds__(NT, 2) fwd(Args a) {
    extern __shared__ __attribute__((aligned(16))) unsigned char lds_raw[];
    LAS unsigned char* lds = (LAS unsigned char*)lds_raw;
    volatile LAS unsigned* MISC = (volatile LAS unsigned*)(lds + MISC_OFF);
    const int tid0 = threadIdx.x, lane0 = tid0 & 63, wave = __builtin_amdgcn_readfirstlane(tid0 >> 6);
    const int G = gridDim.x; const int bxid = blockIdx.x;
    const int vcu = (G % 8 == 0) ? (bxid % 8) * (G / 8) + bxid / 8 : bxid;
    const int gw = vcu * NWAVES + wave, NGW = G * NWAVES;
    for (int u = tid0; u < (LDS_BYTES - RING_BYTES) / 4; u += NT) ((LAS unsigned*)(lds + RING_BYTES))[u] = 0u;
    __syncthreads();
    XcdBarrier bar = xcd_barrier_post((unsigned*)(a.ws + WS_CTL) + CW_BAR, MISC + 8);

    { ARGS
    {
    for (int r = gw; r < TA; r += NGW) {
        bf16_t* orow = hn + (size_t)r * D;
        unsigned char* orow8 = P1_QKV_FP8 ? hn8 + (size_t)r * D : nullptr;
        if (r < T) rms_row_bf16(x + (size_t)r * D, g_mix, orow, lane, orow8);
        else if (r < T + NMETA) rms_row_bf16(meta + (size_t)(r - T) * D, g_mix, orow, lane, orow8);
        else { u32x2* o8 = (u32x2*)orow; for (int j = 0; j < 8; ++j) o8[lane + 64 * j] = (u32x2){0u, 0u};
               if (orow8) for (int j = 0; j < 8; ++j) ((unsigned*)orow8)[lane + 64 * j] = 0u; }
    }
    for (int idx = vcu * NT + tid; idx < NE * D; idx += G * NT) {
        const int e = idx >> 11, k = idx & (D - 1);
        const float v = g_ffn[k] * rw[(size_t)k * NE + e]; const unsigned hi = f2bf(v); const float res = v - bf2f(hi);
        wrT[idx] = (bf16_t)hi; wrT[NE * D + idx] = (bf16_t)f2bf(res);
    }
    { LAS float* scr = (LAS float*)(lds + wave * 16384);
      constexpr int NB0 = P1_QKV_FP8 ? QKV_COLS / 32 : 0, NBW = 272 - NB0;
      constexpr int I_IN = 32 * NBW, I_AO = 16 * 64, I_OUT = P5_FP8 ? 16 * 64 : 32 * 64, I_IN8 = P1_QKV_FP8 ? 16 * (QKV_COLS / 32) : 0;
      constexpr int NITEMS = I_IN + 2 * I_AO + I_OUT + I_IN8;
      for (int it = gw; it < NITEMS; it += NGW) {
          int r = it;
          if (r < I_IN) { p0_transpose_item(w_in, IN_DIM, winT, D, 0, scr, r / NBW, NB0 + r % NBW, lane); continue; } r -= I_IN;
          if (r < I_IN8) { p0_convert_item_fp8(w_in, IN_DIM, winT8, D, r / (QKV_COLS / 32), r % (QKV_COLS / 32), lane); continue; } r -= I_IN8;
          if (r < I_AO) { p0_transpose_item(w_ao, D, wacT, D, 0, scr, r / 64, r % 64, lane); continue; } r -= I_AO;
          if (r < I_AO) { p0_transpose_item(w_co, D, wacT, D, ADIM, scr, r / 64, r % 64, lane); continue; } r -= I_AO;
          if constexpr (P5_FP8) p0_convert_item_fp8(w_out, D, (unsigned char*)woutT, D, r / 64, r % 64, lane);
          else p0_transpose_item(w_out, D, woutT, D, 0, scr, r / 64, r % 64, lane);
      } }
    }
    }
    xcd_barrier(bar);

    { ARGS
    {
        const int GG = (G >= 256 && (G & 7) == 0) ? CONV_GG : G;
        if (bxid < GG) {
          if constexpr (P1_QKV_FP8) {
            { pg8::DenseOrder S; S.init(hn8, winT8, D / 2, D / 2, T, QKV_COLS, GG, bxid, 2, 4); pg8::EpiProj E{proj, 1.0f / (WSCALE * HSCALE)};
              pg8::gemm_phase<pg8::EpiProj, pg8::DenseOrder, true, true>(lds, D, D, D, S, E); }
            { pg8::DenseOrder S; S.init(hn, winT + (size_t)QKV_COLS * D, D, D, T, IN_DIM - QKV_COLS, GG, bxid, 12, 0); S.colbase = QKV_COLS; pg8::EpiProj E{proj, 1.0f};
              pg8::gemm_phase<pg8::EpiProj, pg8::DenseOrder, true>(lds, D * 2, D * 2, D * 2, S, E); }
          } else { pg8::DenseOrder S; S.init(hn, winT, D, D, T, IN_DIM, GG, bxid, 14, 4);
          pg8::EpiProj E{proj, 1.0f};
          pg8::gemm_phase<pg8::EpiProj, pg8::DenseOrder, true>(lds, D * 2, D * 2, D * 2, S, E); } }
        int nxt = 0; if (lane == 0) nxt = (int)atomicAdd(&ctl[CW_CQ], 1u);
        for (;;) {
            const int chunk = __builtin_amdgcn_readfirstlane(nxt);
            if (chunk >= MOE_CHUNKS) break;
            if (lane == 0) nxt = (int)atomicAdd(&ctl[CW_CQ], 1u);
            moe_convert_chunk(chunk, wgu, wd, wguT8, wdT8, lane);
        }
    }
    }
    xcd_barrier(bar);

    { ARGS
    for (int u = bxid; u < 256; u += G) {
        __syncthreads();
        attn_unit(lds, proj, sink, ac, u >> 7, (u >> 2) & 31, u & 3);
    }
    for (int idx = vcu * NT + tid; idx < T * (CDIM / 8); idx += G * NT) {
        const int r = idx >> 7, c = (idx & 127) * 8, s = r & (SEQ - 1);
        const bf16_t* p = proj + (size_t)r * IN_DIM + c;
        const bf16_t* pm = (s == 0) ? proj + (size_t)(T + NMETA - 1) * IN_DIM + c : p - IN_DIM;
        const u32x4 c1 = *(const u32x4*)(p + OFF_CC), h1v = *(const u32x4*)(p + OFF_CH), c0 = *(const u32x4*)(pm + OFF_CC), h0v = *(const u32x4*)(pm + OFF_CH), cb = *(const u32x4*)(p + OFF_CB);
        u32x4 c2 = (u32x4){0u, 0u, 0u, 0u}, h2v = (u32x4){0u, 0u, 0u, 0u};
        if (s != SEQ - 1) { c2 = *(const u32x4*)(p + IN_DIM + OFF_CC); h2v = *(const u32x4*)(p + IN_DIM + OFF_CH); }
        const f32x4 w0a = *(const f32x4*)(conv_w + c), w0b = *(const f32x4*)(conv_w + c + 4), w1a = *(const f32x4*)(conv_w + CDIM + c), w1b = *(const f32x4*)(conv_w + CDIM + c + 4),
                    w2a = *(const f32x4*)(conv_w + 2 * CDIM + c), w2b = *(const f32x4*)(conv_w + 2 * CDIM + c + 4);
        float o[8];
#pragma unroll
        for (int q = 0; q < 4; ++q) {
            const unsigned a0 = c0[q], b0 = h0v[q], a1 = c1[q], b1 = h1v[q], a2 = c2[q], b2 = h2v[q], gb = cb[q];
            const float wl0 = (q < 2) ? w0a[2 * q] : w0b[2 * q - 4], wh0 = (q < 2) ? w0a[2 * q + 1] : w0b[2 * q - 3];
            const float wl1 = (q < 2) ? w1a[2 * q] : w1b[2 * q - 4], wh1 = (q < 2) ? w1a[2 * q + 1] : w1b[2 * q - 3];
            const float wl2 = (q < 2) ? w2a[2 * q] : w2b[2 * q - 4], wh2 = (q < 2) ? w2a[2 * q + 1] : w2b[2 * q - 3];
            o[2 * q] = bflo(gb) * (bflo(a0) * bflo(b0) * wl0 + bflo(a1) * bflo(b1) * wl1 + bflo(a2) * bflo(b2) * wl2);
            o[2 * q + 1] = bfhi(gb) * (bfhi(a0) * bfhi(b0) * wh0 + bfhi(a1) * bfhi(b1) * wh1 + bfhi(a2) * bfhi(b2) * wh2);
        }
        u32x4 w; w.x = pk2(o[0], o[1]); w.y = pk2(o[2], o[3]); w.z = pk2(o[4], o[5]); w.w = pk2(o[6], o[7]);
        *(u32x4*)(ac + (size_t)r * D + ADIM + c) = w;
    }
    }
    xcd_barrier(bar);

    { ARGS
    { pg8::DenseOrder S; S.init(ac, wacT, D, D, T, D, G, bxid); pg8::EpiGated E{proj, merged};
      pg8::gemm_phase<pg8::EpiGated, pg8::DenseOrder, false, false, false, true>(lds, D * 2, D * 2, D * 2, S, E); }
    }
    xcd_barrier(bar);

    { ARGS
    if constexpr (P5_FP8) { pg8::DenseOrder S; S.init(merged, woutT, D / 2, D / 2, T, D, G, bxid); pg8::EpiH1 E{x, h1, 1.0f / (WSCALE * MSCALE)};
      pg8::gemm_phase<pg8::EpiH1, pg8::DenseOrder, false, true>(lds, D, D, D, S, E); }
    else { pg8::DenseOrder S; S.init(merged, woutT, D, D, T, D, G, bxid); pg8::EpiH1 E{x, h1, 1.0f};
      pg8::gemm_phase<pg8::EpiH1, pg8::DenseOrder, false>(lds, D * 2, D * 2, D * 2, S, E); }
    }
    xcd_barrier(bar);

    { ARGS
    {
        f32x4 gg[8];
#pragma unroll
        for (int j = 0; j < 8; ++j) gg[j] = ((const f32x4*)g_ffn)[lane + 64 * j];
        LAS float* pr = (LAS float*)lds;
        LAS float* tinf = (LAS float*)(lds + 32768);
        LAS unsigned* cntL = (LAS unsigned*)(lds + 36864); LAS unsigned* baseL = cntL + NE;
        const int r = lane & 15, q = lane >> 4;
        for (int blk = vcu; blk < T / 32; blk += G) {
            const int tb = blk * 32;
            {
                const int task = wave & 1, kq = wave >> 1, t0 = tb + 16 * task;
                const float* xrow = h1 + (size_t)(t0 + r) * D + 512 * kq + 8 * q;
                const bf16_t* wh = wrT + (size_t)r * D + 512 * kq + 8 * q; const bf16_t* wl = wh + NE * D;
                f32x4 acc0 = (f32x4){0.f, 0.f, 0.f, 0.f}, acc1 = (f32x4){0.f, 0.f, 0.f, 0.f}; float ssq = 0.f;
#pragma unroll 8
                for (int ks = 0; ks < 16; ++ks) {
                    const f32x4 x0 = *(const f32x4*)(xrow + 32 * ks), x1 = *(const f32x4*)(xrow + 32 * ks + 4);
                    ssq += (x0.x * x0.x + x0.y * x0.y) + (x0.z * x0.z + x0.w * x0.w) + (x1.x * x1.x + x1.y * x1.y) + (x1.z * x1.z + x1.w * x1.w);
                    unsigned hb[8]; float rs8[8];
#pragma unroll
                    for (int i = 0; i < 4; ++i) { hb[i] = f2bf(x0[i]); rs8[i] = x0[i] - bf2f(hb[i]); hb[4 + i] = f2bf(x1[i]); rs8[4 + i] = x1[i] - bf2f(hb[4 + i]); }
                    u32x4 ahw, alw;
                    ahw.x = hb[0] | (hb[1] << 16); ahw.y = hb[2] | (hb[3] << 16); ahw.z = hb[4] | (hb[5] << 16); ahw.w = hb[6] | (hb[7] << 16);
                    alw.x = pk2(rs8[0], rs8[1]); alw.y = pk2(rs8[2], rs8[3]); alw.z = pk2(rs8[4], rs8[5]); alw.w = pk2(rs8[6], rs8[7]);
                    const bf16x8 ah = __builtin_bit_cast(bf16x8, ahw), al = __builtin_bit_cast(bf16x8, alw);
                    const bf16x8 bh0 = *(const bf16x8*)(wh + 32 * ks), bh1 = *(const bf16x8*)(wh + 16 * D + 32 * ks), bl0 = *(const bf16x8*)(wl + 32 * ks), bl1 = *(const bf16x8*)(wl + 16 * D + 32 * ks);
                    acc0 = __builtin_amdgcn_mfma_f32_16x16x32_bf16(ah, bh0, acc0, 0, 0, 0); acc0 = __builtin_amdgcn_mfma_f32_16x16x32_bf16(ah, bl0, acc0, 0, 0, 0); acc0 = __builtin_amdgcn_mfma_f32_16x16x32_bf16(al, bh0, acc0, 0, 0, 0);
                    acc1 = __builtin_amdgcn_mfma_f32_16x16x32_bf16(ah, bh1, acc1, 0, 0, 0); acc1 = __builtin_amdgcn_mfma_f32_16x16x32_bf16(ah, bl1, acc1, 0, 0, 0); acc1 = __builtin_amdgcn_mfma_f32_16x16x32_bf16(al, bh1, acc1, 0, 0, 0);
                }
                LAS float* p = pr + (wave * 64 + lane) * 9;
                p[0] = acc0[0]; p[1] = acc0[1]; p[2] = acc0[2]; p[3] = acc0[3]; p[4] = acc1[0]; p[5] = acc1[1]; p[6] = acc1[2]; p[7] = acc1[3]; p[8] = ssq;
                if (wave == 2 && lane < NE) cntL[lane] = 0u;
            }
            __syncthreads();
            int mye = 0, lrank = 0; float myg = 0.f, rstd_r = 0.f;
            if (wave < 2) {
                const int t0 = tb + 16 * wave;
                f32x4 acc0 = (f32x4){0.f, 0.f, 0.f, 0.f}, acc1 = (f32x4){0.f, 0.f, 0.f, 0.f}; float ssq = 0.f;
#pragma unroll
                for (int k4 = 0; k4 < 4; ++k4) { const LAS float* p = pr + ((k4 * 2 + wave) * 64 + lane) * 9;
                    acc0[0] += p[0]; acc0[1] += p[1]; acc0[2] += p[2]; acc0[3] += p[3]; acc1[0] += p[4]; acc1[1] += p[5]; acc1[2] += p[6]; acc1[3] += p[7]; ssq += p[8]; }
                ssq += __shfl_xor(ssq, 16); ssq += __shfl_xor(ssq, 32);
                rstd_r = 1.0f / sqrtf(ssq * (1.0f / D) + RMS_EPS);
                const float b0 = rb[r], b1 = rb[r + 16];
                const int jj = r >> 2, kk = r & 3;
#pragma unroll
                for (int j = 0; j < 4; ++j) {
                    const float rs = __shfl(rstd_r, 4 * q + j);
                    float v0 = acc0[j] * rs + b0, v1 = acc1[j] * rs + b1;
                    float sv[4]; int se[4];
#pragma unroll
                    for (int k = 0; k < 4; ++k) {
                        float bv = v0; int be = r; if (v1 > v0) { bv = v1; be = r + 16; }
#pragma unroll
                        for (int o = 1; o < 16; o <<= 1) { const float ov = __shfl_xor(bv, o); const int oe = __shfl_xor(be, o); if (ov > bv || (ov == bv && oe < be)) { bv = ov; be = oe; } }
                        sv[k] = bv; se[k] = be; if (be == r) v0 = -3.0e38f; if (be == r + 16) v1 = -3.0e38f;
                    }
                    const float e1 = __expf(sv[1] - sv[0]), e2 = __expf(sv[2] - sv[0]), e3 = __expf(sv[3] - sv[0]), inv = 1.0f / (1.0f + e1 + e2 + e3);
                    const int se_k = (kk == 0) ? se[0] : (kk == 1) ? se[1] : (kk == 2) ? se[2] : se[3];
                    const float g_k = ((kk == 0) ? 1.0f : (kk == 1) ? e1 : (kk == 2) ? e2 : e3) * inv;
                    if (jj == j) { mye = se_k; myg = g_k; }
                }
                lrank = (int)__hip_atomic_fetch_add(cntL + mye, 1u, __ATOMIC_RELAXED, __HIP_MEMORY_SCOPE_WORKGROUP);
            }
            __syncthreads();
            if (wave == 0 && lane < NE) { const unsigned c = cntL[lane]; baseL[lane] = c ? atomicAdd(&ctl[CW_CNT + 64 * lane], c) : 0u; }
            __syncthreads();
            if (wave < 2) {
                const int t0 = tb + 16 * wave, kk = lane & 3;
                const int slot = mye * ECAP + (int)baseL[mye] + lrank;
                gatel[slot] = myg; pos[(t0 + (lane >> 2)) * 4 + kk] = slot;
                if (lane < 16) tinf[(16 * wave + lane) * 8] = rstd_r;
                ((LAS int*)tinf)[(16 * wave + (lane >> 2)) * 8 + 1 + kk] = slot;
            }
            __syncthreads();
#pragma unroll
            for (int i = 0; i < 4; ++i) {
                const int tt = 4 * wave + i;
                const float rs = tinf[tt * 8];
                const int s0 = ((const LAS int*)tinf)[tt * 8 + 1], s1 = ((const LAS int*)tinf)[tt * 8 + 2], s2 = ((const LAS int*)tinf)[tt * 8 + 3], s3 = ((const LAS int*)tinf)[tt * 8 + 4];
                const f32x4* xr = (const f32x4*)(h1 + (size_t)(tb + tt) * D);
                unsigned* o0 = (unsigned*)(xs8 + (size_t)s0 * D); unsigned* o1 = (unsigned*)(xs8 + (size_t)s1 * D); unsigned* o2 = (unsigned*)(xs8 + (size_t)s2 * D); unsigned* o3 = (unsigned*)(xs8 + (size_t)s3 * D);
#pragma unroll
                for (int j = 0; j < 8; ++j) { const f32x4 v = xr[lane + 64 * j]; const unsigned w = pg8::pk4_fp8(v.x * rs * gg[j].x, v.y * rs * gg[j].y, v.z * rs * gg[j].z, v.w * rs * gg[j].w);
                    o0[lane + 64 * j] = w; o1[lane + 64 * j] = w; o2[lane + 64 * j] = w; o3[lane + 64 * j] = w; }
            }
            if (blk + G < T / 32) __syncthreads();
        }
    }
    }
    xcd_barrier(bar);

    { ARGS
    { pg8::MoeOrder S; S.init(xs8, wguT8, ctl, DFF / 128, (size_t)2 * DFF * D, DFF, G, bxid); pg8::EpiAct E{bgu, act8};
      pg8::gemm_phase<pg8::EpiAct, pg8::MoeOrder, true, true>(lds, D, D, D, S, E); }
    }
    xcd_barrier(bar);

    { ARGS
    { pg8::MoeOrder S; S.init(act8, wdT8, ctl, D / 256, (size_t)D * DFF, 0, G, bxid); pg8::EpiY E{bd, gatel, yr};
      pg8::gemm_phase<pg8::EpiY, pg8::MoeOrder, true, true>(lds, DFF, DFF, DFF, S, E); }
    }
    xcd_barrier(bar);

    { ARGS
    for (int t = gw; t < T; t += NGW) {
        const f32x4* xr = (const f32x4*)(h1 + (size_t)t * D); const f32x4* gr = (const f32x4*)g_fin;
        f32x4 v[8];
#pragma unroll
        for (int j = 0; j < 8; ++j) v[j] = xr[lane + 64 * j];
#pragma unroll
        for (int k = 0; k < 4; ++k) {
            const int* y4 = (const int*)(yr + (size_t)pos[t * 4 + k] * D);
#pragma unroll
            for (int j = 0; j < 8; ++j) { const int w = y4[lane + 64 * j]; const f32x2 lo = __builtin_amdgcn_cvt_pk_f32_fp8(w, false), hi = __builtin_amdgcn_cvt_pk_f32_fp8(w, true);
                v[j].x += lo.x * YSCALE_INV; v[j].y += lo.y * YSCALE_INV; v[j].z += hi.x * YSCALE_INV; v[j].w += hi.y * YSCALE_INV; }
        }
        float s = 0.f;
#pragma unroll
        for (int j = 0; j < 8; ++j) s += (v[j].x * v[j].x + v[j].y * v[j].y) + (v[j].z * v[j].z + v[j].w * v[j].w);
        s = wave_sum(s);
        const float rstd = 1.0f / sqrtf(s * (1.0f / D) + RMS_EPS);
        f32x4* orow = (f32x4*)(out + (size_t)t * D);
#pragma unroll
        for (int j = 0; j < 8; ++j) { const f32x4 gg = gr[lane + 64 * j]; f32x4 y; y.x = v[j].x * rstd * gg.x; y.y = v[j].y * rstd * gg.y; y.z = v[j].z * rstd * gg.z; y.w = v[j].w * rstd * gg.w; orow[lane + 64 * j] = y; }
    }

    }
}
}

extern "C" void kernel_launch(void* const* d_in, const int* in_sizes, int n_in, void* d_out, int out_size, void* d_ws, size_t ws_size, hipStream_t stream) {
    static int grid = 0;
    if (grid == 0) {
        if (n_in != 17 || out_size != T * D || ws_size < WS_END) { fprintf(stderr, "kernel_launch: unexpected shapes (n_in %d out %d ws %zu, need %zu)\n", n_in, out_size, ws_size, (size_t)WS_END); grid = -1; return; }
        int dev = 0, cus = 0, per_cu = 0;
        if (hipGetDevice(&dev) != hipSuccess || hipDeviceGetAttribute(&cus, hipDeviceAttributeMultiprocessorCount, dev) != hipSuccess) { grid = -1; return; }
        if (hipFuncSetAttribute((const void*)fwd, hipFuncAttributeMaxDynamicSharedMemorySize, LDS_BYTES) != hipSuccess) { fprintf(stderr, "kernel_launch: hipFuncSetAttribute failed\n"); grid = -1; return; }
        if (hipOccupancyMaxActiveBlocksPerMultiprocessor(&per_cu, (const void*)fwd, NT, LDS_BYTES) != hipSuccess || per_cu < 1) { fprintf(stderr, "kernel_launch: occupancy query says %d blocks per CU\n", per_cu); grid = -1; return; }
        (void)hipGetLastError();
        grid = cus;
    }
    if (grid < 0) return;
    if (hipMemsetAsync((char*)d_ws + WS_CTL, 0, CTL_BYTES, stream) != hipSuccess) return;
    Args a{};
    for (int i = 0; i < 17; ++i) a.in[i] = (const float*)d_in[i];
    a.out = (float*)d_out; a.ws = (unsigned char*)d_ws;
    hipLaunchKernelGGL(fwd, dim3(grid), dim3(NT), LDS_BYTES, stream, a);
}
```

```cpp
#include <hip/hip_runtime.h>
#include <stdint.h>
#include <stdio.h>

namespace {
#define LAS __attribute__((address_space(3)))
typedef unsigned short bf16_t;
typedef short bf16x8 __attribute__((ext_vector_type(8)));
typedef float f32x4 __attribute__((ext_vector_type(4)));
typedef float f32x2 __attribute__((ext_vector_type(2)));
typedef unsigned u32x4 __attribute__((ext_vector_type(4)));
typedef unsigned u32x2 __attribute__((ext_vector_type(2)));

constexpr int NT = 512, NWAVES = 8;
constexpr int D = 2048, SEQ = 4096, NMETA = 16, T = 8192;
constexpr int TA = T + 256;
constexpr int ADIM = 1024, KVDIM = 256, CDIM = 1024, IN_DIM = 8704;
constexpr int OFF_Q = 0, OFF_K = 1024, OFF_V = 1280, OFF_CH = 1536, OFF_CB = 2560, OFF_CC = 3584, OFF_GA = 4608, OFF_GC = 6656;
constexpr int NE = 32, DFF = 2048, ECAP = 8192;
constexpr float RMS_EPS = 1e-5f;
constexpr float WSCALE = 32.0f, WSCALE_INV = 1.0f / 32.0f;
constexpr bool P5_FP8 = true;
constexpr float MSCALE = 8.0f;
constexpr bool P4_ATT_FP8 = true;
constexpr float ASCALE = 64.0f;
constexpr int AC_PITCH = P4_ATT_FP8 ? 3072 : 4096;
constexpr int AC_CONV_OFF = P4_ATT_FP8 ? 1024 : 2048;
constexpr float YSCALE = 16.0f, YSCALE_INV = 1.0f / 16.0f;

constexpr size_t MiB = 1u << 20;
constexpr size_t WS_CTL = 0, CTL_BYTES = 1 * MiB;
constexpr size_t WS_HN = 1 * MiB;
constexpr size_t WS_PROJ = WS_HN + 35 * MiB;
constexpr size_t WS_AC = WS_PROJ + 142 * MiB;
constexpr size_t WS_M1 = WS_AC + 32 * MiB;
constexpr size_t WS_MERGED = WS_M1 + 64 * MiB;
constexpr size_t WS_H1 = WS_MERGED + 32 * MiB;
constexpr size_t WS_GATEL = WS_H1 + 64 * MiB;
constexpr size_t WS_POS = WS_GATEL + 1 * MiB;
constexpr size_t WS_WRT = WS_POS + 512 * 1024;
constexpr size_t WS_XS = WS_POS + 1 * MiB;
constexpr size_t WS_ACT = WS_XS + 1024 * MiB;
constexpr size_t WS_WIN = WS_ACT + 1024 * MiB;
constexpr size_t WS_WAC = WS_WIN + 34 * MiB;
constexpr size_t WS_WOUT = WS_WAC + 8 * MiB;
constexpr size_t WS_WGU = WS_WOUT + 8 * MiB;
constexpr size_t WS_WD = WS_WGU + 512 * MiB;
constexpr size_t WS_END = WS_WD + 256 * MiB;
constexpr int CW_CNT = 1024;
constexpr int CW_CQ = 3584;
constexpr int CW_BAR = 4096;

constexpr int RING_BYTES = 131072, MISC_OFF = RING_BYTES + 320, LDS_BYTES = 147456;

__device__ __forceinline__ unsigned f2bf(float f) { unsigned u = __float_as_uint(f); return (u + 0x7fffu + ((u >> 16) & 1u)) >> 16; }
__device__ __forceinline__ unsigned pk2(float lo, float hi) { return f2bf(lo) | (f2bf(hi) << 16); }
__device__ __forceinline__ float bf2f(unsigned b) { return __uint_as_float(b << 16); }
__device__ __forceinline__ float bflo(unsigned w) { return __uint_as_float(w << 16); }
__device__ __forceinline__ float bfhi(unsigned w) { return __uint_as_float(w & 0xffff0000u); }
__device__ __forceinline__ float wave_sum(float v) {
#pragma unroll
    for (int o = 32; o >= 1; o >>= 1) v += __shfl_xor(v, o);
    return v;
}
__device__ __forceinline__ float sigmoidf_(float x) { return __builtin_amdgcn_rcpf(1.0f + __builtin_amdgcn_exp2f(x * -1.4426950408889634f)); }

__constant__ float c_invrev[8] = {0.15915494309189535f, 0.03086376340470123f, 0.005985185712713705f, 0.001160663641240061f,
                                  0.00022507907903927653f, 4.364795279280289e-05f, 8.464330808241401e-06f, 1.6414262627950345e-06f};

#define XB_TMO      128
#define XB_XCNT(j)  (256  + 64 * (j))
#define XB_XSUB(j)  (1280 + 64 * (j))
#define XB_XGEN(j)  (2304 + 64 * (j))
#define XB_TOP      3328
#define XB_TOPGEN   3392
#define XCD_BAR_WORDS 3456
#define XB_SPIN_CAP (1u << 18)

__device__ __forceinline__ unsigned xb_ld(unsigned* p)              { return __hip_atomic_load(p, __ATOMIC_RELAXED, __HIP_MEMORY_SCOPE_AGENT); }
__device__ __forceinline__ unsigned xb_add(unsigned* p, unsigned v) { return __hip_atomic_fetch_add(p, v, __ATOMIC_RELAXED, __HIP_MEMORY_SCOPE_AGENT); }
__device__ __forceinline__ unsigned xb_xcc_id() { return (unsigned)__builtin_amdgcn_s_getreg((3 << 11) | 20) & 0xFu; }
#define XB_SPIN(cond, bar) do { unsigned _sp = 0; while (cond) { __builtin_amdgcn_s_sleep(1); \
    if ((++_sp & 255u) == 0u) { if (xb_ld(&(bar)[XB_TMO])) break; if (_sp > XB_SPIN_CAP) { atomicAdd(&(bar)[XB_TMO], 1u); break; } } } } while (0)

struct XcdBarrier {
    unsigned* bar; unsigned x;
    volatile LAS unsigned* st;
};

__device__ __forceinline__ XcdBarrier xcd_barrier_post(unsigned* bar, volatile LAS unsigned* st) {
    XcdBarrier b; b.bar = bar; b.x = xb_xcc_id(); b.st = st;
    if (threadIdx.x == 0) (void)xb_add(&bar[XB_XCNT(b.x)], 1u);
    return b;
}
__device__ __forceinline__ void xcd_barrier_complete(unsigned* bar, unsigned x, unsigned& nloc, unsigned& nx) {
    const unsigned G = gridDim.x * gridDim.y * gridDim.z;
    unsigned sum, cnt, mine, sp = 0u;
    for (;;) {
        sum = 0u; cnt = 0u; mine = 0u;
#pragma unroll
        for (unsigned j = 0; j < 16; ++j) { const unsigned c = xb_ld(&bar[XB_XCNT(j)]); sum += c; cnt += (c > 0u) ? 1u : 0u; mine = (j == x) ? c : mine; }
        if (sum == G) break;
        __builtin_amdgcn_s_sleep(1);
        if ((++sp & 255u) == 0u) { if (xb_ld(&bar[XB_TMO])) break; if (sp > XB_SPIN_CAP) { atomicAdd(&bar[XB_TMO], 1u); break; } }
    }
    nloc = mine > 0u ? mine : 1u; nx = cnt > 0u ? cnt : 1u;
}

__device__ __forceinline__ void xcd_barrier(const XcdBarrier& b) {
    asm volatile("s_waitcnt vmcnt(0)" ::: "memory");
    __syncthreads();
    if (threadIdx.x == 0) {
        unsigned* bar = b.bar;
        __builtin_amdgcn_s_waitcnt(0);
        unsigned nloc = b.st[0], nx = b.st[1];
        if (nloc == 0u) { xcd_barrier_complete(bar, b.x, nloc, nx); b.st[0] = nloc; b.st[1] = nx; }
        const unsigned old = xb_add(&bar[XB_XSUB(b.x)], 1u);
        const unsigned gen = old / nloc;
        if (old + 1u == (gen + 1u) * nloc) {
            __builtin_amdgcn_fence(__ATOMIC_RELEASE, "agent");
            asm volatile("s_waitcnt vmcnt(0)" ::: "memory");
            const unsigned og = xb_add(&bar[XB_TOP], 1u);
            const unsigned tg = og / nx;
            if (og + 1u == (tg + 1u) * nx) xb_add(&bar[XB_TOPGEN], 1u);
            else XB_SPIN(xb_ld(&bar[XB_TOPGEN]) == tg, bar);
            __builtin_amdgcn_fence(__ATOMIC_ACQUIRE, "agent");
            xb_add(&bar[XB_XGEN(b.x)], 1u);
            asm volatile("s_waitcnt vmcnt(0)" ::: "memory");
        } else {
            XB_SPIN(xb_ld(&bar[XB_XGEN(b.x)]) == gen, bar);
            __builtin_amdgcn_fence(__ATOMIC_ACQUIRE, "agent");
            asm volatile("s_waitcnt vmcnt(0)" ::: "memory");
        }
    }
    __syncthreads();
}

__device__ __forceinline__ void rms_row_bf16(const float* xrow, const float* g, bf16_t* orow, int lane) {
    const f32x4* xr = (const f32x4*)xrow; const f32x4* gr = (const f32x4*)g;
    f32x4 v[8]; float s = 0.f;
#pragma unroll
    for (int j = 0; j < 8; ++j) { v[j] = xr[lane + 64 * j]; s += (v[j].x * v[j].x + v[j].y * v[j].y) + (v[j].z * v[j].z + v[j].w * v[j].w); }
    s = wave_sum(s);
    const float rstd = 1.0f / sqrtf(s * (1.0f / D) + RMS_EPS);
    u32x2* o8 = (u32x2*)orow;
#pragma unroll
    for (int j = 0; j < 8; ++j) { const f32x4 gg = gr[lane + 64 * j]; u32x2 w; w.x = pk2(v[j].x * rstd * gg.x, v[j].y * rstd * gg.y); w.y = pk2(v[j].z * rstd * gg.z, v[j].w * rstd * gg.w); o8[lane + 64 * j] = w; }
}

namespace pg8 {
constexpr int BM = 256, BK = 64, HALF = 128, HTB = HALF * BK * 2  , STAGE_BYTES = 8 * HTB, NXCD = 8, WGM = 8;
__host__ __device__ __forceinline__ int lds_byte(int r, int c) { const int st = (r >> 4) * 2 + (c >> 5), rr = r & 15, cc = c & 31, ob = rr * 64 + cc * 2; return st * 1024 + (ob ^ (((ob >> 9) & 1) << 5)); }
__host__ __device__ __forceinline__ void stage_rc(int b, int& R, int& C) { const int st = b / 1024, sb = b % 1024, swz = sb ^ (((sb >> 9) & 1) << 5); R = (st >> 1) * 16 + swz / 64; C = (st & 1) * 32 + (swz % 64) / 2; }
__host__ __device__ __forceinline__ int perm32(int rho) { const int n = rho >> 4, i = rho & 15; return 8 * (i >> 2) + 4 * n + (i & 3); }

struct Unit { const char* a0; const char* a1; const char* b0; const char* b1; int row0, col0, e; };
typedef int v8i __attribute__((ext_vector_type(8)));
typedef int v4i __attribute__((ext_vector_type(4)));
__device__ __forceinline__ v8i cat8(bf16x8 a, bf16x8 b) { const v4i x = __builtin_bit_cast(v4i, a), y = __builtin_bit_cast(v4i, b); return (v8i){x[0], x[1], x[2], x[3], y[0], y[1], y[2], y[3]}; }
__device__ __forceinline__ unsigned pk4_fp8(float a, float b, float c, float d) { int r = 0; r = __builtin_amdgcn_cvt_pk_fp8_f32(a, b, r, false); r = __builtin_amdgcn_cvt_pk_fp8_f32(c, d, r, true); return (unsigned)r; }
__device__ __forceinline__ unsigned cvt_pk_bf16(float lo, float hi) { unsigned r; asm volatile("v_cvt_pk_bf16_f32 %0, %1, %2" : "=v"(r) : "v"(lo), "v"(hi)); return r; }

__device__ __forceinline__ int xcd_remap(int L, int nwg) { const int q = nwg / NXCD, r = nwg % NXCD, xcd = L % NXCD, off = L / NXCD; return (xcd < r ? xcd * (q + 1) : r * (q + 1) + (xcd - r) * q) + off; }

__device__ __forceinline__ void glds16_s(const char* sbase, unsigned voff, unsigned lds_dst) {
    unsigned keep;
    asm volatile("s_mov_b32 %0, m0\n\ts_mov_b32 m0, %3\n\ts_nop 2\n\tglobal_load_lds_dwordx4 %1, %2\n\ts_mov_b32 m0, %0" : "=&s"(keep) : "v"(voff), "s"(sbase), "s"(lds_dst) : "memory");
}
__device__ __forceinline__ void mfma_fp8_inplace(f32x4& c, v8i a, v8i b, int scale) {
    asm volatile("v_mfma_scale_f32_16x16x128_f8f6f4 %0, %1, %2, %0, %3, %3 op_sel_hi:[0,0,0]" : "+v"(c) : "v"(a), "v"(b), "v"(scale));
}
__device__ __forceinline__ void mfma_bf16_inplace(f32x4& c, bf16x8 a, bf16x8 b) {
    asm volatile("v_mfma_f32_16x16x32_bf16 %0, %1, %2, %0" : "+v"(c) : "v"(a), "v"(b));
}
__device__ __forceinline__ void mfma_fp8_first(f32x4& c, v8i a, v8i b, int scale) {
    asm volatile("v_mfma_scale_f32_16x16x128_f8f6f4 %0, %1, %2, 0, %3, %3 op_sel_hi:[0,0,0]" : "+v"(c) : "v"(a), "v"(b), "v"(scale));
}
constexpr int CI_GU = NE * 32 * 128, CI_DN = NE * 32 * 64, MOE_ITEMS64 = CI_GU + CI_DN;
struct ConvJob { const float* wgu; const float* wd; unsigned char* wguT8; unsigned char* wdT8; int j, stride; };
__device__ __forceinline__ void conv_decode(const ConvJob& c, int jc, const char*& src, unsigned char*& dst, int& N) {
    const bool gu = jc < CI_GU; const int jj = gu ? jc : jc - CI_GU;
    const int e = gu ? (jj >> 12) : (jj >> 11), kb = gu ? ((jj >> 7) & 31) : ((jj >> 6) & 31), nb = gu ? (jj & 127) : (jj & 63); N = gu ? 2 * DFF : D;
    src = (const char*)(gu ? c.wgu : c.wd) + ((size_t)e * D * N + (size_t)(64 * kb) * N + 32 * nb) * 4;
    dst = (gu ? c.wguT8 : c.wdT8) + (size_t)e * N * D + (size_t)(32 * nb) * D + 64 * kb;
}
__device__ __forceinline__ void conv_load(f32x4& v, const char* sbase, unsigned voff) { asm volatile("global_load_dwordx4 %0, %1, %2 nt" : "=v"(v) : "v"(voff), "s"(sbase) : "memory"); }
__device__ __forceinline__ void conv_store(unsigned char* dst, int lane, const f32x4& v0, const f32x4& v1, const f32x4& v2, const f32x4& v3, const f32x4& v4, const f32x4& v5, const f32x4& v6, const f32x4& v7) {
    unsigned char* dp = dst + (lane & 7) * (4 * D) + (lane >> 3) * 8;
#pragma unroll
    for (int jn = 0; jn < 4; ++jn) { u32x2 o; o.x = pk4_fp8(v0[jn] * WSCALE, v1[jn] * WSCALE, v2[jn] * WSCALE, v3[jn] * WSCALE); o.y = pk4_fp8(v4[jn] * WSCALE, v5[jn] * WSCALE, v6[jn] * WSCALE, v7[jn] * WSCALE);
        *(u32x2*)(dp + jn * D) = o; }
}
__device__ __forceinline__ void conv_item_sync(const ConvJob& c, int jc, int lane) {
    const char* src; unsigned char* dst; int N; conv_decode(c, jc, src, dst, N);
    const float* sp = (const float*)src + (size_t)(lane >> 3) * 8 * N + (lane & 7) * 4;
    f32x4 v[8];
#pragma unroll
    for (int i = 0; i < 8; ++i) v[i] = *(const f32x4*)(sp + (size_t)i * N);
    conv_store(dst, lane, v[0], v[1], v[2], v[3], v[4], v[5], v[6], v[7]);
}
template <class Epi, class Sched, bool ALIGN_EPI, bool FP8 = false, bool CONV = false, bool MID = false, int MIX8 = 0>
__device__ __forceinline__ void gemm_phase(LAS unsigned char* lds, const int KB, const int lda, const int ldb, const Sched& S, const Epi& E, ConvJob* cj = nullptr) {
    const int tid = threadIdx.x, wid = __builtin_amdgcn_readfirstlane(tid >> 6), lane = tid & 63, wr = wid >> 2, wc = wid & 3, fr = lane & 15, fq = lane >> 4;
    const int nt = KB / (BK * 2);
    unsigned voffA, voffB;
    { int R, C; stage_rc(tid * 16, R, C); const int Rb = (R & ~31) + perm32(R & 31); voffA = (unsigned)(R * lda + C * 2); voffB = (unsigned)(Rb * ldb + C * 2); }
    const size_t p1A = (size_t)64 * lda, p1B = (size_t)64 * ldb;
    const size_t kstep = (size_t)(BK * 2);
    const unsigned ldsw = (unsigned)wid * 1024u;
    const int aoff = lds_byte(wr * 64 + fr, fq * 8), boff = lds_byte(wc * 32 + fr, fq * 8);
#define PG8_SA(b, h) (((b) * 2 + (h)) * HTB)
#define PG8_SB(b, h) ((4 + (b) * 2 + (h)) * HTB)
#define PG8_STAGE(bufoff, gbase, voff) do { \
        glds16_s((const char*)(gbase), (voff), (unsigned)(size_t)(lds + (bufoff) + ldsw)); \
        glds16_s((const char*)(gbase) + (&(voff) == &voffA ? p1A : p1B), (voff), (unsigned)(size_t)(lds + (bufoff) + ldsw + 8192)); } while (0)
#define PG8_LDA(dst, b, h) do { _Pragma("unroll") for (int m = 0; m < 4; ++m) _Pragma("unroll") for (int k = 0; k < 2; ++k) dst[m][k] = *(const LAS bf16x8*)(lds + PG8_SA(b, h) + aoff + m * 2048 + k * 1024); } while (0)
#define PG8_LDB(dst, b, h) do { _Pragma("unroll") for (int n = 0; n < 2; ++n) _Pragma("unroll") for (int k = 0; k < 2; ++k) dst[n][k] = *(const LAS bf16x8*)(lds + PG8_SB(b, h) + boff + n * 2048 + k * 1024); } while (0)
#define PG8_MMA(ai, bj, At, Bt, FIRST) do { __builtin_amdgcn_s_setprio(1); \
        if constexpr (MIX8 > 0) { if (f8seg) { _Pragma("unroll") for (int m = 0; m < 4; ++m) _Pragma("unroll") for (int n = 0; n < 2; ++n) \
            mfma_fp8_inplace(acc[ai][bj][m][n], cat8(Bt[n][0], Bt[n][1]), cat8(At[m][0], At[m][1]), scale1); } \
          else { _Pragma("unroll") for (int k = 0; k < 2; ++k) _Pragma("unroll") for (int m = 0; m < 4; ++m) _Pragma("unroll") for (int n = 0; n < 2; ++n) \
            mfma_bf16_inplace(acc[ai][bj][m][n], Bt[n][k], At[m][k]); } }   \
        else if constexpr (FP8) { if (FIRST) { _Pragma("unroll") for (int m = 0; m < 4; ++m) _Pragma("unroll") for (int n = 0; n < 2; ++n) \
            mfma_fp8_first(acc[ai][bj][m][n], cat8(Bt[n][0], Bt[n][1]), cat8(At[m][0], At[m][1]), scale1); } \
          else { _Pragma("unroll") for (int m = 0; m < 4; ++m) _Pragma("unroll") for (int n = 0; n < 2; ++n) \
            mfma_fp8_inplace(acc[ai][bj][m][n], cat8(Bt[n][0], Bt[n][1]), cat8(At[m][0], At[m][1]), scale1); } } \
        else { _Pragma("unroll") for (int m = 0; m < 4; ++m) _Pragma("unroll") for (int n = 0; n < 2; ++n) _Pragma("unroll") for (int k = 0; k < 2; ++k) \
            acc[ai][bj][m][n] = __builtin_amdgcn_mfma_f32_16x16x32_bf16(Bt[n][k], At[m][k], acc[ai][bj][m][n], 0, 0, 0); } \
        __builtin_amdgcn_s_setprio(0); } while (0)
#define PG8_WAIT_V(n) asm volatile("s_waitcnt vmcnt(" #n ")" ::: "memory")
#define PG8_WAIT_L(n) asm volatile("s_waitcnt lgkmcnt(" #n ")" ::: "memory")
#define PG8_BAR __builtin_amdgcn_s_barrier()
#define PG8_SCHED __builtin_amdgcn_sched_barrier(0)
    Unit cur, nxt; int ui = 0;
    if (!S.next(0, cur)) return;
    const int scale1 = 0x7f7f7f7f;
    f32x4 acc[2][2][4][2];
#pragma unroll
    for (int a = 0; a < 2; ++a)
#pragma unroll
        for (int b = 0; b < 2; ++b)
#pragma unroll
            for (int m = 0; m < 4; ++m)
#pragma unroll
                for (int n = 0; n < 2; ++n) acc[a][b][m][n] = (f32x4){0.f, 0.f, 0.f, 0.f};
    bf16x8 At[4][2], B0[2][2], B1[2][2];
    const char* cA0 = cur.a0; const char* cA1 = cur.a1; const char* cB0 = cur.b0; const char* cB1 = cur.b1;
    PG8_STAGE(PG8_SB(0, 0), cB0, voffB); PG8_STAGE(PG8_SB(0, 1), cB1, voffB); PG8_STAGE(PG8_SA(0, 0), cA0, voffA); PG8_STAGE(PG8_SA(0, 1), cA1, voffA);
    if (wr == 1) PG8_BAR;
    PG8_WAIT_V(2); PG8_BAR;
    PG8_STAGE(PG8_SB(1, 0), cB0 + kstep, voffB); PG8_STAGE(PG8_SA(1, 0), cA0 + kstep, voffA); PG8_STAGE(PG8_SB(1, 1), cB1 + kstep, voffB);
    PG8_WAIT_V(6); PG8_BAR;
    for (;;) {
        const bool has_next = S.next(ui + 1, nxt);
        const char* nA0 = has_next ? nxt.a0 : cA0; const char* nA1 = has_next ? nxt.a1 : cA1; const char* nB0 = has_next ? nxt.b0 : cB0; const char* nB1 = has_next ? nxt.b1 : cB1;
        const int tsplit = MID ? (MIX8 > 0 ? MIX8 : nt / 2) : nt;
        _Pragma("unroll") for (int seg = 0; seg < (MID ? 2 : 1); ++seg) { const int t0 = seg ? tsplit : 0;
        if constexpr (MID) { if (t0 != 0) { if constexpr (MIX8 > 0) asm volatile("s_nop 15\n\ts_nop 15" ::: "memory"); E.mid(acc, cur, wr, wc, fr, fq); } }
        const int tend = (seg == 0) ? tsplit : nt;
        for (int t = t0; t < tend; t += 2) {
            const bool f8seg = (MIX8 > 0) && (seg == 0); (void)f8seg;
            const bool last = (t == nt - 2), first = FP8 && (t == 0);
            const char* a1_1 = cA1 + (size_t)(t + 1) * kstep;
            const char* a2_0 = last ? nA0 : cA0 + (size_t)(t + 2) * kstep; const char* a2_1 = last ? nA1 : cA1 + (size_t)(t + 2) * kstep;
            const char* b2_0 = last ? nB0 : cB0 + (size_t)(t + 2) * kstep; const char* b2_1 = last ? nB1 : cB1 + (size_t)(t + 2) * kstep;
            const char* a3_0 = a2_0 + kstep; const char* b3_0 = b2_0 + kstep; const char* b3_1 = b2_1 + kstep;
            f32x4 cv0, cv1, cv2, cv3, cv4, cv5, cv6, cv7; unsigned char* cdst = nullptr;
            PG8_LDB(B0, 0, 0); PG8_LDB(B1, 0, 1); PG8_SCHED; PG8_LDA(At, 0, 0);
            if constexpr (CONV) { const int jc = cj->j < MOE_ITEMS64 ? cj->j : MOE_ITEMS64 - 1; cj->j += cj->stride;
                const char* csrc; int cN; conv_decode(*cj, jc, csrc, cdst, cN); const unsigned cvl = (unsigned)((lane >> 3) * (cN * 32) + (lane & 7) * 16); const size_t crow = (size_t)cN * 4;
                conv_load(cv0, csrc, cvl); conv_load(cv1, csrc + crow, cvl); conv_load(cv2, csrc + 2 * crow, cvl); conv_load(cv3, csrc + 3 * crow, cvl);
                conv_load(cv4, csrc + 4 * crow, cvl); conv_load(cv5, csrc + 5 * crow, cvl); conv_load(cv6, csrc + 6 * crow, cvl); conv_load(cv7, csrc + 7 * crow, cvl); }
            PG8_STAGE(PG8_SA(1, 1), a1_1, voffA);
            if constexpr (CONV) PG8_WAIT_V(20); else PG8_WAIT_V(8);
            PG8_WAIT_L(0); PG8_BAR; PG8_MMA(0, 0, At, B0, first); PG8_MMA(0, 1, At, B1, first); PG8_BAR; PG8_SCHED;
            PG8_LDA(At, 0, 1); PG8_STAGE(PG8_SB(0, 0), b2_0, voffB); PG8_STAGE(PG8_SB(0, 1), b2_1, voffB); PG8_STAGE(PG8_SA(0, 0), a2_0, voffA);
            if constexpr (CONV) PG8_WAIT_V(16); else PG8_WAIT_V(8);
            PG8_WAIT_L(0); PG8_BAR; PG8_MMA(1, 0, At, B0, first); PG8_MMA(1, 1, At, B1, first); PG8_BAR; PG8_SCHED;
            PG8_LDB(B0, 1, 0); PG8_LDB(B1, 1, 1); PG8_SCHED; PG8_LDA(At, 1, 0); PG8_STAGE(PG8_SA(0, 1), a2_1, voffA);
            PG8_WAIT_V(8); PG8_WAIT_L(0); PG8_BAR;
            if constexpr (CONV) { asm volatile("" : "+v"(cv0), "+v"(cv1), "+v"(cv2), "+v"(cv3), "+v"(cv4), "+v"(cv5), "+v"(cv6), "+v"(cv7));
                conv_store(cdst, lane, cv0, cv1, cv2, cv3, cv4, cv5, cv6, cv7); }
            PG8_MMA(0, 0, At, B0, false); PG8_MMA(0, 1, At, B1, false); PG8_BAR; PG8_SCHED;
            PG8_LDA(At, 1, 1); PG8_STAGE(PG8_SB(1, 0), b3_0, voffB); PG8_STAGE(PG8_SB(1, 1), b3_1, voffB); PG8_STAGE(PG8_SA(1, 0), a3_0, voffA);
            if constexpr (CONV) PG8_WAIT_V(12); else PG8_WAIT_V(8);
            PG8_WAIT_L(0); PG8_BAR; PG8_MMA(1, 0, At, B0, false); PG8_MMA(1, 1, At, B1, false); PG8_BAR; PG8_SCHED;
        }
        }
        if constexpr (ALIGN_EPI) { if (wr == 0) PG8_BAR; }
        if constexpr (FP8 || MIX8 > 0) asm volatile("s_nop 15\n\ts_nop 15" ::: "memory");
        E(acc, cur, wr, wc, fr, fq);
        if (!has_next) break;
        if constexpr (!FP8)
#pragma unroll
        for (int a = 0; a < 2; ++a)
#pragma unroll
            for (int b = 0; b < 2; ++b)
#pragma unroll
                for (int m = 0; m < 4; ++m)
#pragma unroll
                    for (int n = 0; n < 2; ++n) acc[a][b][m][n] = (f32x4){0.f, 0.f, 0.f, 0.f};
        cur = nxt; cA0 = nA0; cA1 = nA1; cB0 = nB0; cB1 = nB1; ++ui;
        if constexpr (ALIGN_EPI) { if (wr == 1) PG8_BAR; }
    }
    PG8_WAIT_V(0);
    if constexpr (!ALIGN_EPI) { if (wr == 0) PG8_BAR; }
    PG8_BAR;
#undef PG8_SA
#undef PG8_SB
#undef PG8_STAGE
#undef PG8_LDA
#undef PG8_LDB
#undef PG8_MMA
#undef PG8_WAIT_V
#undef PG8_WAIT_L
#undef PG8_BAR
#undef PG8_SCHED
}

struct DenseOrder {
    const char* A; const char* Bt; int lda2, ldb2;
    int nM, nN, nwg, G, c, extra, xlo;
    __device__ void init(const void* A_, const void* Bt_, int lda, int ldb, int M, int N, int G_, int c_, int extra_ = 0, int xlo_ = 0) {
        A = (const char*)A_; Bt = (const char*)Bt_; lda2 = lda * 2; ldb2 = ldb * 2; nM = M / BM; nN = N / BM; nwg = nM * nN; G = G_; c = c_; extra = extra_; xlo = xlo_; }
    __device__ __forceinline__ bool next(int i, Unit& u) const {
        const int L = i * G + c; int pm, pn;
        if (L >= nwg + extra) return false;
        if (L >= nwg) { pm = nM; pn = xlo + (L - nwg); }
        else { const int wgid = xcd_remap(L, nwg); const int nig = WGM * nN, gid = wgid / nig, fm = gid * WGM, gsz = (nM - fm) < WGM ? (nM - fm) : WGM;
            pm = fm + ((wgid % nig) % gsz); pn = (wgid % nig) / gsz; }
        u.a0 = A + (size_t)pm * BM * lda2; u.a1 = u.a0 + (size_t)HALF * lda2; u.b0 = Bt + (size_t)pn * BM * ldb2; u.b1 = u.b0 + (size_t)HALF * ldb2;
        u.row0 = pm * BM; u.col0 = pn * BM; u.e = 0; return true;
    }
};
struct MoeOrder {
    const char* A; const char* Bt; int npn, G, c, nU; size_t estrideB; int up_off;
    int nrt_l, incl_l;
    __device__ __forceinline__ void init(const void* A_, const void* Bt_, unsigned* ctl, int npn_, size_t estrideB_, int up_off_, int G_, int c_) {
        A = (const char*)A_; Bt = (const char*)Bt_; npn = npn_; estrideB = estrideB_; up_off = up_off_; G = G_; c = c_;
        const int lane = threadIdx.x & 63;
        const int cnt = (lane < NE) ? (int)__hip_atomic_load(ctl + CW_CNT + 64 * lane, __ATOMIC_RELAXED, __HIP_MEMORY_SCOPE_AGENT) : 0;
        nrt_l = (cnt + 255) >> 8; int p = nrt_l;
#pragma unroll
        for (int o = 1; o < 32; o <<= 1) { const int t = __shfl_up(p, o); if (lane >= o) p += t; }
        incl_l = p; nU = __builtin_amdgcn_readlane(p, 31) * npn; }
    __device__ __forceinline__ bool next(int i, Unit& u) const {
        const int L = i * G + c; if (L >= nU) return false;
        const int idx = xcd_remap(L, nU), q = idx / npn, lane = threadIdx.x & 63;
        const int e = __builtin_amdgcn_readfirstlane(__builtin_popcountll(__ballot(lane < NE && incl_l <= q)));
        const int nrt = __builtin_amdgcn_readlane(nrt_l, e), pe = __builtin_amdgcn_readlane(incl_l, e) - nrt;
        const int rem = idx - pe * npn, pn = rem / nrt, rt = rem - pn * nrt;
        u.row0 = e * ECAP + rt * BM; u.e = e;
        u.a0 = A + (size_t)u.row0 * D; u.a1 = u.a0 + (size_t)HALF * D;
        const char* be = Bt + (size_t)e * estrideB;
        if (up_off) { u.col0 = pn * HALF; u.b0 = be + (size_t)(pn * HALF) * D; u.b1 = be + (size_t)(up_off + pn * HALF) * D; }
        else { u.col0 = pn * BM; u.b0 = be + (size_t)(pn * BM) * D; u.b1 = u.b0 + (size_t)HALF * D; }
        return true;
    }
};

#define EPI_ROWS() _Pragma("unroll") for (int ai = 0; ai < 2; ++ai) _Pragma("unroll") for (int m = 0; m < 4; ++m)
struct EpiProj {
    bf16_t* proj;
    __device__ __forceinline__ void operator()(const f32x4 (&acc)[2][2][4][2], const Unit& u, int wr, int wc, int fr, int fq) const {
        const int r0 = u.row0 + wr * 64 + fr, c0 = u.col0 + wc * 32 + 8 * fq;
        const bool rope = (u.col0 < OFF_V) && ((wc & 1) == 0);
        const bool gate = (u.col0 >= OFF_GA);
        EPI_ROWS() { const int r = r0 + ai * HALF + m * 16; bf16_t* rowp = proj + (size_t)r * IN_DIM + c0;
            float cs[8], sn[8];
            if (rope) { const float ps = (float)((r < T) ? (NMETA + (r & (SEQ - 1))) : (r - T));
#pragma unroll
                for (int i = 0; i < 8; ++i) { float rev = ps * c_invrev[i]; rev -= floorf(rev); sn[i] = __builtin_amdgcn_sinf(rev); cs[i] = __builtin_amdgcn_cosf(rev); } }
#pragma unroll
            for (int bj = 0; bj < 2; ++bj) { f32x4 v0 = acc[ai][bj][m][0], v1 = acc[ai][bj][m][1];
                if (rope) {
#pragma unroll
                    for (int i = 0; i < 4; ++i) { const float o0 = __shfl_xor(v0[i], 16), o1 = __shfl_xor(v1[i], 16);
                        const float a0 = (fq == 0) ? v0[i] * cs[i] - o0 * sn[i] : v0[i] * cs[i] + o0 * sn[i], a1 = (fq == 0) ? v1[i] * cs[4 + i] - o1 * sn[4 + i] : v1[i] * cs[4 + i] + o1 * sn[4 + i];
                        if (fq < 2) { v0[i] = a0; v1[i] = a1; } } }
                if (gate) {
#pragma unroll
                    for (int i = 0; i < 4; ++i) { v0[i] = sigmoidf_(fmaxf(v0[i], -60.f)); v1[i] = sigmoidf_(fmaxf(v1[i], -60.f)); } }
                u32x4 w; w.x = cvt_pk_bf16(v0[0], v0[1]); w.y = cvt_pk_bf16(v0[2], v0[3]); w.z = cvt_pk_bf16(v1[0], v1[1]); w.w = cvt_pk_bf16(v1[2], v1[3]);
                *(u32x4*)(rowp + bj * HALF) = w; } }
    }
};
struct EpiM1 {
    const bf16_t* proj; float* m1;
    __device__ __forceinline__ void operator()(const f32x4 (&acc)[2][2][4][2], const Unit& u, int wr, int wc, int fr, int fq) const {
        const int r0 = u.row0 + wr * 64 + fr, c0 = u.col0 + wc * 32 + 8 * fq;
        EPI_ROWS() { const int r = r0 + ai * HALF + m * 16;
#pragma unroll
            for (int bj = 0; bj < 2; ++bj) { const int c = c0 + bj * HALF; const u32x4 g = *(const u32x4*)(proj + (size_t)r * IN_DIM + OFF_GA + c);
                const f32x4 v0 = acc[ai][bj][m][0], v1 = acc[ai][bj][m][1]; f32x4 o0, o1;
                o0[0] = sigmoidf_(bflo(g.x)) * v0[0]; o0[1] = sigmoidf_(bfhi(g.x)) * v0[1]; o0[2] = sigmoidf_(bflo(g.y)) * v0[2]; o0[3] = sigmoidf_(bfhi(g.y)) * v0[3];
                o1[0] = sigmoidf_(bflo(g.z)) * v1[0]; o1[1] = sigmoidf_(bfhi(g.z)) * v1[1]; o1[2] = sigmoidf_(bflo(g.w)) * v1[2]; o1[3] = sigmoidf_(bfhi(g.w)) * v1[3];
                float* op = m1 + (size_t)r * D + c; *(f32x4*)op = o0; *(f32x4*)(op + 4) = o1; } }
    }
};
struct EpiMerged {
    const bf16_t* proj; const float* m1; bf16_t* merged;
    __device__ __forceinline__ void operator()(const f32x4 (&acc)[2][2][4][2], const Unit& u, int wr, int wc, int fr, int fq) const {
        const int r0 = u.row0 + wr * 64 + fr, c0 = u.col0 + wc * 32 + 8 * fq;
        EPI_ROWS() { const int r = r0 + ai * HALF + m * 16;
#pragma unroll
            for (int bj = 0; bj < 2; ++bj) { const int c = c0 + bj * HALF; const u32x4 g = *(const u32x4*)(proj + (size_t)r * IN_DIM + OFF_GC + c);
                const float* mp = m1 + (size_t)r * D + c; const f32x4 p0 = *(const f32x4*)mp, p1 = *(const f32x4*)(mp + 4);
                const f32x4 v0 = acc[ai][bj][m][0], v1 = acc[ai][bj][m][1]; u32x4 w;
                w.x = cvt_pk_bf16(p0[0] + sigmoidf_(bflo(g.x)) * v0[0], p0[1] + sigmoidf_(bfhi(g.x)) * v0[1]); w.y = cvt_pk_bf16(p0[2] + sigmoidf_(bflo(g.y)) * v0[2], p0[3] + sigmoidf_(bfhi(g.y)) * v0[3]);
                w.z = cvt_pk_bf16(p1[0] + sigmoidf_(bflo(g.z)) * v1[0], p1[1] + sigmoidf_(bfhi(g.z)) * v1[1]); w.w = cvt_pk_bf16(p1[2] + sigmoidf_(bflo(g.w)) * v1[2], p1[3] + sigmoidf_(bfhi(g.w)) * v1[3]);
                *(u32x4*)(merged + (size_t)r * D + c) = w; } }
    }
};
struct EpiGated {
    const bf16_t* proj; bf16_t* merged;
    __device__ __forceinline__ void mid(f32x4 (&acc)[2][2][4][2], const Unit& u, int wr, int wc, int fr, int fq) const {
        asm volatile("" : "+v"(fr), "+v"(fq));
        const int r0 = u.row0 + wr * 64 + fr, c0 = u.col0 + wc * 32 + 8 * fq;
        constexpr int MB = 4;
#pragma unroll
        for (int ai = 0; ai < 2; ++ai)
#pragma unroll
            for (int m0 = 0; m0 < 4; m0 += MB) {
                u32x4 ga[MB][2], gc[MB][2];
#pragma unroll
                for (int mm = 0; mm < MB; ++mm)
#pragma unroll
                    for (int bj = 0; bj < 2; ++bj) { const bf16_t* gp = proj + (size_t)(r0 + ai * HALF + (m0 + mm) * 16) * IN_DIM + c0 + bj * HALF; ga[mm][bj] = *(const u32x4*)(gp + OFF_GA); gc[mm][bj] = *(const u32x4*)(gp + OFF_GC); }
#pragma unroll
                for (int mm = 0; mm < MB; ++mm)
#pragma unroll
                    for (int bj = 0; bj < 2; ++bj)
#pragma unroll
                        for (int q = 0; q < 4; ++q) {
                            constexpr float KS = P4_ATT_FP8 ? 1.0f / (ASCALE * WSCALE) : 1.0f;
                            const float fl = bflo(ga[mm][bj][q]) * KS * __builtin_amdgcn_rcpf(bflo(gc[mm][bj][q])), fh = bfhi(ga[mm][bj][q]) * KS * __builtin_amdgcn_rcpf(bfhi(gc[mm][bj][q]));
                            acc[ai][bj][m0 + mm][q >> 1][(q & 1) * 2] *= fl; acc[ai][bj][m0 + mm][q >> 1][(q & 1) * 2 + 1] *= fh; }
                asm volatile("" ::: "memory"); }
    }
    __device__ __forceinline__ void operator()(const f32x4 (&acc)[2][2][4][2], const Unit& u, int wr, int wc, int fr, int fq) const {
        const int r0 = u.row0 + wr * 64 + fr, c0 = u.col0 + wc * 32 + 8 * fq;
#pragma unroll
        for (int ai = 0; ai < 2; ++ai) {
            u32x4 g[4][2];
#pragma unroll
            for (int m = 0; m < 4; ++m)
#pragma unroll
                for (int bj = 0; bj < 2; ++bj) g[m][bj] = *(const u32x4*)(proj + (size_t)(r0 + ai * HALF + m * 16) * IN_DIM + OFF_GC + c0 + bj * HALF);
#pragma unroll
            for (int m = 0; m < 4; ++m)
#pragma unroll
                for (int bj = 0; bj < 2; ++bj) { const u32x4 gg = g[m][bj]; const f32x4 v0 = acc[ai][bj][m][0], v1 = acc[ai][bj][m][1]; u32x4 w;
                    if constexpr (P5_FP8) { u32x2 w8;
                        w8.x = pk4_fp8(bflo(gg.x) * v0[0] * MSCALE, bfhi(gg.x) * v0[1] * MSCALE, bflo(gg.y) * v0[2] * MSCALE, bfhi(gg.y) * v0[3] * MSCALE);
                        w8.y = pk4_fp8(bflo(gg.z) * v1[0] * MSCALE, bfhi(gg.z) * v1[1] * MSCALE, bflo(gg.w) * v1[2] * MSCALE, bfhi(gg.w) * v1[3] * MSCALE);
                        *(u32x2*)((unsigned char*)merged + (size_t)(r0 + ai * HALF + m * 16) * D + c0 + bj * HALF) = w8; }
                    else {
                    w.x = cvt_pk_bf16(bflo(gg.x) * v0[0], bfhi(gg.x) * v0[1]); w.y = cvt_pk_bf16(bflo(gg.y) * v0[2], bfhi(gg.y) * v0[3]);
                    w.z = cvt_pk_bf16(bflo(gg.z) * v1[0], bfhi(gg.z) * v1[1]); w.w = cvt_pk_bf16(bflo(gg.w) * v1[2], bfhi(gg.w) * v1[3]);
                    *(u32x4*)(merged + (size_t)(r0 + ai * HALF + m * 16) * D + c0 + bj * HALF) = w; } }
            asm volatile("" ::: "memory"); }
    }
};
struct EpiH1 {
    const float* x; float* h1; float sc;
    __device__ __forceinline__ void operator()(const f32x4 (&acc)[2][2][4][2], const Unit& u, int wr, int wc, int fr, int fq) const {
        const int r0 = u.row0 + wr * 64 + fr, c0 = u.col0 + wc * 32 + 8 * fq;
#pragma unroll
        for (int ai = 0; ai < 2; ++ai) {
            f32x4 xv[4][2][2];
#pragma unroll
            for (int m = 0; m < 4; ++m)
#pragma unroll
                for (int bj = 0; bj < 2; ++bj) { const size_t o = (size_t)(r0 + ai * HALF + m * 16) * D + c0 + bj * HALF; xv[m][bj][0] = *(const f32x4*)(x + o); xv[m][bj][1] = *(const f32x4*)(x + o + 4); }
#pragma unroll
            for (int m = 0; m < 4; ++m)
#pragma unroll
                for (int bj = 0; bj < 2; ++bj) { const size_t o = (size_t)(r0 + ai * HALF + m * 16) * D + c0 + bj * HALF;
                    *(f32x4*)(h1 + o) = xv[m][bj][0] + acc[ai][bj][m][0] * (f32x4){sc, sc, sc, sc}; *(f32x4*)(h1 + o + 4) = xv[m][bj][1] + acc[ai][bj][m][1] * (f32x4){sc, sc, sc, sc}; }
            asm volatile("" ::: "memory"); }
    }
};
struct EpiAct {
    const float* bgu; unsigned char* act;
    __device__ __forceinline__ void operator()(const f32x4 (&acc)[2][2][4][2], const Unit& u, int wr, int wc, int fr, int fq) const {
        const int r0 = u.row0 + wr * 64 + fr, c = u.col0 + wc * 32 + 8 * fq;
        const float* bp = bgu + (size_t)u.e * (2 * DFF) + c;
        const f32x4 bg0 = *(const f32x4*)bp, bg1 = *(const f32x4*)(bp + 4), bu0 = *(const f32x4*)(bp + DFF), bu1 = *(const f32x4*)(bp + DFF + 4);
        const f32x2 ws2 = (f32x2){WSCALE_INV, WSCALE_INV}, one2 = (f32x2){1.0f, 1.0f}, k2 = (f32x2){-1.702f * 1.4426950408889634f, -1.702f * 1.4426950408889634f};
        EPI_ROWS() { const int r = r0 + ai * HALF + m * 16; f32x2 o[4];
#pragma unroll
            for (int n = 0; n < 2; ++n)
#pragma unroll
                for (int h = 0; h < 2; ++h) { const f32x4 ag = acc[ai][0][m][n], au = acc[ai][1][m][n], bgv = n ? bg1 : bg0, buv = n ? bu1 : bu0;
                    f32x2 g = (f32x2){ag[2 * h], ag[2 * h + 1]} * ws2 + (f32x2){bgv[2 * h], bgv[2 * h + 1]}, up = (f32x2){au[2 * h], au[2 * h + 1]} * ws2 + (f32x2){buv[2 * h], buv[2 * h + 1]};
                    g.x = fminf(g.x, 7.0f); g.y = fminf(g.y, 7.0f); up.x = fminf(fmaxf(up.x, -7.0f), 7.0f); up.y = fminf(fmaxf(up.y, -7.0f), 7.0f);
                    const f32x2 t = g * k2; f32x2 d = (f32x2){__builtin_amdgcn_exp2f(t.x), __builtin_amdgcn_exp2f(t.y)} + one2;
                    const f32x2 rc = (f32x2){__builtin_amdgcn_rcpf(d.x), __builtin_amdgcn_rcpf(d.y)};
                    o[n * 2 + h] = (up + one2) * g * rc; }
            u32x2 w; w.x = pk4_fp8(o[0].x, o[0].y, o[1].x, o[1].y); w.y = pk4_fp8(o[2].x, o[2].y, o[3].x, o[3].y);
            *(u32x2*)(act + (size_t)r * DFF + c) = w; }
    }
};
struct EpiY {
    const float* bd; const float* gatel; unsigned char* yr;
    __device__ __forceinline__ void operator()(const f32x4 (&acc)[2][2][4][2], const Unit& u, int wr, int wc, int fr, int fq) const {
        const int r0 = u.row0 + wr * 64 + fr, c0 = u.col0 + wc * 32 + 8 * fq;
        f32x4 bv[2][2];
#pragma unroll
        for (int bj = 0; bj < 2; ++bj) { const float* bp = bd + (size_t)u.e * D + c0 + bj * HALF; bv[bj][0] = *(const f32x4*)bp; bv[bj][1] = *(const f32x4*)(bp + 4); }
        EPI_ROWS() { const int r = r0 + ai * HALF + m * 16; const float g = gatel[r] * YSCALE;
#pragma unroll
            for (int bj = 0; bj < 2; ++bj) { const f32x4 v0 = (acc[ai][bj][m][0] * (f32x4){WSCALE_INV, WSCALE_INV, WSCALE_INV, WSCALE_INV} + bv[bj][0]) * (f32x4){g, g, g, g}, v1 = (acc[ai][bj][m][1] * (f32x4){WSCALE_INV, WSCALE_INV, WSCALE_INV, WSCALE_INV} + bv[bj][1]) * (f32x4){g, g, g, g}; u32x2 w;
                w.x = pk4_fp8(v0[0], v0[1], v0[2], v0[3]); w.y = pk4_fp8(v1[0], v1[1], v1[2], v1[3]);
                *(u32x2*)(yr + (size_t)r * D + c0 + bj * HALF) = w; } }
    }
};
}

__device__ __forceinline__ void p0_transpose_item(const float* W, int N, bf16_t* WT, int ldt, int koff, LAS float* scr, int kb, int nb, int lane) {
    const int k0 = 64 * kb, n0 = 32 * nb;
    float v[32];
    const float* wp = W + (size_t)(k0 + (lane >> 5)) * N + n0 + (lane & 31);
#pragma unroll
    for (int i = 0; i < 32; ++i) v[i] = __builtin_nontemporal_load(wp + (size_t)(2 * i) * N);
#pragma unroll
    for (int i = 0; i < 32; ++i) scr[(2 * i + (lane >> 5)) * 33 + (lane & 31)] = v[i];
    asm volatile("s_waitcnt lgkmcnt(0)" ::: "memory");
    const int c = lane & 7;
#pragma unroll
    for (int j = 0; j < 4; ++j) { const int n = (lane >> 3) + 8 * j; const LAS float* s = scr + (8 * c) * 33 + n;
        u32x4 o; o.x = pk2(s[0 * 33], s[1 * 33]); o.y = pk2(s[2 * 33], s[3 * 33]); o.z = pk2(s[4 * 33], s[5 * 33]); o.w = pk2(s[6 * 33], s[7 * 33]);
        *(u32x4*)(WT + (size_t)(n0 + n) * ldt + koff + k0 + 8 * c) = o; }
    asm volatile("s_waitcnt lgkmcnt(0)" ::: "memory");
}


typedef float f32x16 __attribute__((ext_vector_type(16)));
constexpr int AT_KP = 144, AT_VP = 840, AT_V_OFF = 416 * AT_KP;
__device__ __forceinline__ float xhalf_max(float v) {
    const unsigned u = __builtin_bit_cast(unsigned, v); const auto r = __builtin_amdgcn_permlane32_swap(u, u, false, false);
    return fmaxf(__builtin_bit_cast(float, (unsigned)r[0]), __builtin_bit_cast(float, (unsigned)r[1]));
}
__device__ __forceinline__ void attn_unit(LAS unsigned char* lds, const bf16_t* proj, const float* sink, bf16_t* ac, int b, int nb, int hk) {
    const int tid = threadIdx.x, wave = __builtin_amdgcn_readfirstlane(tid >> 6), lane = tid & 63, r31 = lane & 31, h = lane >> 5;
    const int s0 = 128 * nb - 128;
    const int head = hk * 4 + (wave >> 1), qhalf = wave & 1, ql0 = 64 * qhalf;
    const size_t qrow0 = (size_t)b * SEQ + 128 * nb + ql0 + r31;
    bf16x8 qf0[4], qf1[4];
#pragma unroll
    for (int ks = 0; ks < 4; ++ks) { qf0[ks] = *(const bf16x8*)(proj + qrow0 * IN_DIM + OFF_Q + head * 64 + 16 * ks + 8 * h); qf1[ks] = *(const bf16x8*)(proj + (qrow0 + 32) * IN_DIM + OFF_Q + head * 64 + 16 * ks + 8 * h); }
    {
        u32x4 kvr[7], vvr[7];
#pragma unroll
        for (int it = 0; it < 7; ++it) { const int p = tid + it * NT, slot = p >> 3, ch = p & 7; int krow = 0; bool valid = (p < 416 * 8);
            if (slot < NMETA) krow = T + slot;
            else if (slot < 32) valid = false;
            else { const int sk = s0 + slot - 32; valid = valid && (sk >= 0 && sk < SEQ); krow = b * SEQ + sk; }
            kvr[it] = (u32x4){0u, 0u, 0u, 0u}; vvr[it] = (u32x4){0u, 0u, 0u, 0u};
            if (valid) { const bf16_t* rp = proj + (size_t)krow * IN_DIM + hk * 64 + 8 * ch; kvr[it] = *(const u32x4*)(rp + OFF_K); vvr[it] = *(const u32x4*)(rp + OFF_V); } }
#pragma unroll
        for (int it = 0; it < 7; ++it) { const int p = tid + it * NT, slot = p >> 3, ch = p & 7;
            if (p < 416 * 8) { const u32x4 kv = kvr[it], vv = vvr[it];
                *(LAS u32x4*)(lds + slot * AT_KP + ch * 16) = kv;
                LAS bf16_t* vt = (LAS bf16_t*)(lds + AT_V_OFF + (8 * ch) * AT_VP + slot * 2);
                vt[0 * (AT_VP / 2)] = (bf16_t)(vv.x & 0xffffu); vt[1 * (AT_VP / 2)] = (bf16_t)(vv.x >> 16); vt[2 * (AT_VP / 2)] = (bf16_t)(vv.y & 0xffffu); vt[3 * (AT_VP / 2)] = (bf16_t)(vv.y >> 16);
                vt[4 * (AT_VP / 2)] = (bf16_t)(vv.z & 0xffffu); vt[5 * (AT_VP / 2)] = (bf16_t)(vv.z >> 16); vt[6 * (AT_VP / 2)] = (bf16_t)(vv.w & 0xffffu); vt[7 * (AT_VP / 2)] = (bf16_t)(vv.w >> 16); } }
    }
    __syncthreads();
    const float SC = 0.125f * 1.4426950408889634f, sink2 = sink[head] * 1.4426950408889634f;
    unsigned m_lo = 0u, m_hi = 0u;
#pragma unroll
    for (int rg = 0; rg < 16; ++rg) { const int kr = (rg & 3) + 8 * (rg >> 2) + 4 * h; m_lo |= (kr >= r31) ? (1u << rg) : 0u; m_hi |= (kr <= r31) ? (1u << rg) : 0u; }
    f32x16 Oa0, Oa1, Ob0, Ob1;
#pragma unroll
    for (int i = 0; i < 16; ++i) { Oa0[i] = 0.f; Oa1[i] = 0.f; Ob0[i] = 0.f; Ob1[i] = 0.f; }
    float ma = sink2, la = (h == 0) ? 1.0f : 0.0f, mb = sink2, lb = la;
    for (int ti = 0; ti < 11; ++ti) {
        int slot = 0, mta = 3, mtb = 3;
        if (ti > 0) { const int i = ti - 1, k0 = 128 * nb + ql0 - 128 + 32 * i; if (k0 < 0 || k0 >= SEQ) continue; slot = 32 + ql0 + 32 * i;
            mta = (i == 0) ? 1 : (i == 8) ? 2 : (i == 9) ? 4 : 0; mtb = (i == 0) ? 4 : (i == 1) ? 1 : (i == 9) ? 2 : 0; }
        f32x16 Sa, Sb;
        { const f32x16 Z = (f32x16){0.f, 0.f, 0.f, 0.f, 0.f, 0.f, 0.f, 0.f, 0.f, 0.f, 0.f, 0.f, 0.f, 0.f, 0.f, 0.f};
          const bf16x8 kf = *(const LAS bf16x8*)(lds + (slot + r31) * AT_KP + (8 * h) * 2);
          Sa = __builtin_amdgcn_mfma_f32_32x32x16_bf16(kf, qf0[0], Z, 0, 0, 0); Sb = __builtin_amdgcn_mfma_f32_32x32x16_bf16(kf, qf1[0], Z, 0, 0, 0); }
#pragma unroll
        for (int ks = 1; ks < 4; ++ks) { const bf16x8 kf = *(const LAS bf16x8*)(lds + (slot + r31) * AT_KP + (16 * ks + 8 * h) * 2);
            Sa = __builtin_amdgcn_mfma_f32_32x32x16_bf16(kf, qf0[ks], Sa, 0, 0, 0); Sb = __builtin_amdgcn_mfma_f32_32x32x16_bf16(kf, qf1[ks], Sb, 0, 0, 0); }
        float pa[16], pb[16];
        if (mta != 0) { const unsigned msk = (mta == 1) ? m_lo : (mta == 2) ? m_hi : (mta == 3) ? 0x00ffu : 0u;
#pragma unroll
            for (int rg = 0; rg < 16; ++rg) Sa[rg] = (msk & (1u << rg)) ? Sa[rg] : -1.0e30f; }
        if (mtb != 0) { const unsigned msk = (mtb == 1) ? m_lo : (mtb == 2) ? m_hi : (mtb == 3) ? 0x00ffu : 0u;
#pragma unroll
            for (int rg = 0; rg < 16; ++rg) Sb[rg] = (msk & (1u << rg)) ? Sb[rg] : -1.0e30f; }
        float mxa = Sa[0], mxb = Sb[0];
#pragma unroll
        for (int rg = 1; rg < 16; ++rg) { mxa = fmaxf(mxa, Sa[rg]); mxb = fmaxf(mxb, Sb[rg]); }
        mxa = xhalf_max(mxa); mxb = xhalf_max(mxb);
        const float ca = mxa * SC, cb2 = mxb * SC;
        const float mna = (ca > ma + 8.0f) ? ca : ma, ala = __builtin_amdgcn_exp2f(ma - mna), mnb = (cb2 > mb + 8.0f) ? cb2 : mb, alb = __builtin_amdgcn_exp2f(mb - mnb);
        float psa = 0.f, psb = 0.f;
#pragma unroll
        for (int rg = 0; rg < 16; ++rg) { pa[rg] = __builtin_amdgcn_exp2f(__builtin_fmaf(Sa[rg], SC, -mna)); psa += pa[rg]; pb[rg] = __builtin_amdgcn_exp2f(__builtin_fmaf(Sb[rg], SC, -mnb)); psb += pb[rg]; }
        la = la * ala + psa; ma = mna; lb = lb * alb + psb; mb = mnb;
        if (__any(ala != 1.0f)) {
#pragma unroll
            for (int i = 0; i < 16; ++i) { Oa0[i] *= ala; Oa1[i] *= ala; } }
        if (__any(alb != 1.0f)) {
#pragma unroll
            for (int i = 0; i < 16; ++i) { Ob0[i] *= alb; Ob1[i] *= alb; } }
#pragma unroll
        for (int sx = 0; sx < 2; ++sx) {
            u32x4 pw; pw.x = pg8::cvt_pk_bf16(pa[8 * sx + 0], pa[8 * sx + 1]); pw.y = pg8::cvt_pk_bf16(pa[8 * sx + 2], pa[8 * sx + 3]); pw.z = pg8::cvt_pk_bf16(pa[8 * sx + 4], pa[8 * sx + 5]); pw.w = pg8::cvt_pk_bf16(pa[8 * sx + 6], pa[8 * sx + 7]);
            const bf16x8 pba = __builtin_bit_cast(bf16x8, pw);
            pw.x = pg8::cvt_pk_bf16(pb[8 * sx + 0], pb[8 * sx + 1]); pw.y = pg8::cvt_pk_bf16(pb[8 * sx + 2], pb[8 * sx + 3]); pw.z = pg8::cvt_pk_bf16(pb[8 * sx + 4], pb[8 * sx + 5]); pw.w = pg8::cvt_pk_bf16(pb[8 * sx + 6], pb[8 * sx + 7]);
            const bf16x8 pbb = __builtin_bit_cast(bf16x8, pw);
#pragma unroll
            for (int dt = 0; dt < 2; ++dt) {
                const LAS unsigned char* vp = lds + AT_V_OFF + (32 * dt + r31) * AT_VP + (slot + 16 * sx + 4 * h) * 2;
                const u32x2 lo = *(const LAS u32x2*)vp, hi = *(const LAS u32x2*)(vp + 16);
                u32x4 vw; vw.x = lo.x; vw.y = lo.y; vw.z = hi.x; vw.w = hi.y;
                const bf16x8 vf = __builtin_bit_cast(bf16x8, vw);
                if (dt == 0) { Oa0 = __builtin_amdgcn_mfma_f32_32x32x16_bf16(vf, pba, Oa0, 0, 0, 0); Ob0 = __builtin_amdgcn_mfma_f32_32x32x16_bf16(vf, pbb, Ob0, 0, 0, 0); }
                else { Oa1 = __builtin_amdgcn_mfma_f32_32x32x16_bf16(vf, pba, Oa1, 0, 0, 0); Ob1 = __builtin_amdgcn_mfma_f32_32x32x16_bf16(vf, pbb, Ob1, 0, 0, 0); }
            }
        }
    }
#pragma unroll
    for (int qs = 0; qs < 2; ++qs) {
        float l = qs ? lb : la; l += __shfl_xor(l, 32);
        const float inv = 1.0f / l;
        if constexpr (P4_ATT_FP8) {
            unsigned char* op8 = (unsigned char*)ac + (qrow0 + 32 * qs) * AC_PITCH + head * 64 + 4 * h; const float iv = inv * ASCALE;
#pragma unroll
            for (int rg4 = 0; rg4 < 4; ++rg4) {
                if (qs == 0) { *(unsigned*)(op8 + 8 * rg4) = pg8::pk4_fp8(Oa0[4 * rg4 + 0] * iv, Oa0[4 * rg4 + 1] * iv, Oa0[4 * rg4 + 2] * iv, Oa0[4 * rg4 + 3] * iv);
                    *(unsigned*)(op8 + 32 + 8 * rg4) = pg8::pk4_fp8(Oa1[4 * rg4 + 0] * iv, Oa1[4 * rg4 + 1] * iv, Oa1[4 * rg4 + 2] * iv, Oa1[4 * rg4 + 3] * iv); }
                else { *(unsigned*)(op8 + 8 * rg4) = pg8::pk4_fp8(Ob0[4 * rg4 + 0] * iv, Ob0[4 * rg4 + 1] * iv, Ob0[4 * rg4 + 2] * iv, Ob0[4 * rg4 + 3] * iv);
                    *(unsigned*)(op8 + 32 + 8 * rg4) = pg8::pk4_fp8(Ob1[4 * rg4 + 0] * iv, Ob1[4 * rg4 + 1] * iv, Ob1[4 * rg4 + 2] * iv, Ob1[4 * rg4 + 3] * iv); } }
        } else {
        bf16_t* op = ac + (qrow0 + 32 * qs) * D + head * 64 + 4 * h;
#pragma unroll
        for (int rg4 = 0; rg4 < 4; ++rg4) {
            u32x2 w0, w1;
            if (qs == 0) { w0.x = pg8::cvt_pk_bf16(Oa0[4 * rg4 + 0] * inv, Oa0[4 * rg4 + 1] * inv); w0.y = pg8::cvt_pk_bf16(Oa0[4 * rg4 + 2] * inv, Oa0[4 * rg4 + 3] * inv);
                w1.x = pg8::cvt_pk_bf16(Oa1[4 * rg4 + 0] * inv, Oa1[4 * rg4 + 1] * inv); w1.y = pg8::cvt_pk_bf16(Oa1[4 * rg4 + 2] * inv, Oa1[4 * rg4 + 3] * inv); }
            else { w0.x = pg8::cvt_pk_bf16(Ob0[4 * rg4 + 0] * inv, Ob0[4 * rg4 + 1] * inv); w0.y = pg8::cvt_pk_bf16(Ob0[4 * rg4 + 2] * inv, Ob0[4 * rg4 + 3] * inv);
                w1.x = pg8::cvt_pk_bf16(Ob1[4 * rg4 + 0] * inv, Ob1[4 * rg4 + 1] * inv); w1.y = pg8::cvt_pk_bf16(Ob1[4 * rg4 + 2] * inv, Ob1[4 * rg4 + 3] * inv); }
            *(u32x2*)(op + 8 * rg4) = w0; *(u32x2*)(op + 32 + 8 * rg4) = w1;
        } }
    }
}


__device__ __forceinline__ void conv128_load(f32x4 (&v)[16], const float* W, int N, int kb, int nb, int lane) {
    const float* wp = W + (size_t)(128 * kb + 16 * (lane >> 3)) * N + 32 * nb + 4 * (lane & 7);
#pragma unroll
    for (int i = 0; i < 16; ++i) v[i] = __builtin_nontemporal_load((const f32x4*)(wp + (size_t)i * N));
}
__device__ __forceinline__ void conv128_store(const f32x4 (&v)[16], unsigned char* WT, int ldt, int kb, int nb, int lane) {
    unsigned char* dp = WT + (size_t)(32 * nb + 4 * (lane & 7)) * ldt + 128 * kb + 16 * (lane >> 3);
#pragma unroll
    for (int j = 0; j < 4; ++j) { u32x4 o;
        o.x = pg8::pk4_fp8(v[0][j] * WSCALE, v[1][j] * WSCALE, v[2][j] * WSCALE, v[3][j] * WSCALE); o.y = pg8::pk4_fp8(v[4][j] * WSCALE, v[5][j] * WSCALE, v[6][j] * WSCALE, v[7][j] * WSCALE);
        o.z = pg8::pk4_fp8(v[8][j] * WSCALE, v[9][j] * WSCALE, v[10][j] * WSCALE, v[11][j] * WSCALE); o.w = pg8::pk4_fp8(v[12][j] * WSCALE, v[13][j] * WSCALE, v[14][j] * WSCALE, v[15][j] * WSCALE);
        __builtin_nontemporal_store(o, (u32x4*)(dp + (size_t)j * ldt)); }
}
__device__ __forceinline__ void p0_convert_item_fp8(const float* W, int N, unsigned char* WT, int ldt, int kb, int nb, int lane) {
    f32x4 v[16]; conv128_load(v, W, N, kb, nb, lane); conv128_store(v, WT, ldt, kb, nb, lane);
}
constexpr int I_GU = 16 * 128, I_DN = 16 * 64, MOE_ITEMS = NE * (I_GU + I_DN);
constexpr int MOE_ITEMS_P6 = 0;
constexpr int CONV_GG = 120;
__device__ __forceinline__ void moe_convert_item(int j, const float* wgu, const float* wd, unsigned char* wguT8, unsigned char* wdT8, int lane) {
    if (j < NE * I_GU) { const int e = j / I_GU, q = j % I_GU; p0_convert_item_fp8(wgu + (size_t)e * D * 2 * DFF, 2 * DFF, wguT8 + (size_t)e * 2 * DFF * D, D, q / 128, q % 128, lane); }
    else { j -= NE * I_GU; const int e = j / I_DN, q = j % I_DN; p0_convert_item_fp8(wd + (size_t)e * DFF * D, D, wdT8 + (size_t)e * D * DFF, DFF, q / 64, q % 64, lane); }
}
constexpr int MOE_CHUNKS = MOE_ITEMS / 8;
__device__ __forceinline__ void moe_convert_chunk(int chunk, const float* wgu, const float* wd, unsigned char* wguT8, unsigned char* wdT8, int lane) {
    int j = chunk * 8; const float* W; unsigned char* WT; int N, kb, nb0;
    if (j < NE * I_GU) { const int e = j / I_GU, q = j % I_GU; W = wgu + (size_t)e * D * 2 * DFF; WT = wguT8 + (size_t)e * 2 * DFF * D; N = 2 * DFF; kb = q / 128; nb0 = q % 128; }
    else { j -= NE * I_GU; const int e = j / I_DN, q = j % I_DN; W = wd + (size_t)e * DFF * D; WT = wdT8 + (size_t)e * D * DFF; N = D; kb = q / 64; nb0 = q % 64; }
    f32x4 va[16], vb[16];
    conv128_load(va, W, N, kb, nb0, lane); conv128_load(vb, W, N, kb, nb0 + 1, lane);
#pragma unroll
    for (int k = 0; k < 8; k += 2) {
        conv128_store(va, WT, D, kb, nb0 + k, lane); if (k + 2 < 8) conv128_load(va, W, N, kb, nb0 + k + 2, lane);
        conv128_store(vb, WT, D, kb, nb0 + k + 1, lane); if (k + 3 < 8) conv128_load(vb, W, N, kb, nb0 + k + 3, lane);
    }
}
struct Args { const float* in[17]; float* out; unsigned char* ws; };

typedef const __attribute__((address_space(4))) Args* kargs_t;
#define ARGS \
    kargs_t ap_ = (kargs_t)__builtin_amdgcn_kernarg_segment_ptr(); asm volatile("" : "+s"(ap_)); \
    int tid = tid0; asm volatile("" : "+v"(tid)); const int lane = tid & 63; (void)lane;   \
    unsigned char* const ws = ap_->ws; unsigned* const ctl = (unsigned*)(ws + WS_CTL); \
    const float* const x = ap_->in[0]; const float* const meta = ap_->in[1]; const float* const g_mix = ap_->in[2]; const float* const w_in = ap_->in[3]; \
    const float* const conv_w = ap_->in[4]; const float* const sink = ap_->in[5]; const float* const w_ao = ap_->in[6]; const float* const w_co = ap_->in[7]; \
    const float* const w_out = ap_->in[8]; const float* const g_ffn = ap_->in[9]; const float* const rw = ap_->in[10]; const float* const rb = ap_->in[11]; \
    const float* const wgu = ap_->in[12]; const float* const bgu = ap_->in[13]; const float* const wd = ap_->in[14]; const float* const bd = ap_->in[15]; \
    const float* const g_fin = ap_->in[16]; float* const out = ap_->out; \
    bf16_t* const hn = (bf16_t*)(ws + WS_HN); bf16_t* const proj = (bf16_t*)(ws + WS_PROJ); bf16_t* const ac = (bf16_t*)(ws + WS_AC); \
    float* const m1 = (float*)(ws + WS_M1); bf16_t* const merged = (bf16_t*)(ws + WS_MERGED); float* const h1 = (float*)(ws + WS_H1); \
    float* const gatel = (float*)(ws + WS_GATEL); int* const pos = (int*)(ws + WS_POS); \
    unsigned char* const xs8 = ws + WS_XS; unsigned char* const act8 = ws + WS_ACT; unsigned char* const yr = ws + WS_XS; \
    bf16_t* const wrT = (bf16_t*)(ws + WS_WRT); bf16_t* const winT = (bf16_t*)(ws + WS_WIN); bf16_t* const wacT = (bf16_t*)(ws + WS_WAC); bf16_t* const woutT = (bf16_t*)(ws + WS_WOUT); \
    unsigned char* const wguT8 = ws + WS_WGU; unsigned char* const wdT8 = ws + WS_WD; \
    (void)ctl; (void)x; (void)meta; (void)g_mix; (void)w_in; (void)conv_w; (void)sink; (void)w_ao; (void)w_co; (void)w_out; (void)g_ffn; (void)rw; (void)rb; (void)wgu; (void)bgu; (void)wd; (void)bd; (void)g_fin; (void)out; \
    (void)hn; (void)proj; (void)ac; (void)m1; (void)merged; (void)h1; (void)gatel; (void)pos; (void)xs8; (void)act8; (void)yr; (void)wrT; (void)winT; (void)wacT; (void)woutT; (void)wguT8; (void)wdT8;
__global__ void __launch_bounds__(NT, 2) fwd(Args a) {
    extern __shared__ __attribute__((aligned(16))) unsigned char lds_raw[];
    LAS unsigned char* lds = (LAS unsigned char*)lds_raw;
    volatile LAS unsigned* MISC = (volatile LAS unsigned*)(lds + MISC_OFF);
    const int tid0 = threadIdx.x, lane0 = tid0 & 63, wave = __builtin_amdgcn_readfirstlane(tid0 >> 6);
    const int G = gridDim.x; const int bxid = blockIdx.x;
    const int vcu = (G % 8 == 0) ? (bxid % 8) * (G / 8) + bxid / 8 : bxid;
    const int gw = vcu * NWAVES + wave, NGW = G * NWAVES;
    for (int u = tid0; u < (LDS_BYTES - RING_BYTES) / 4; u += NT) ((LAS unsigned*)(lds + RING_BYTES))[u] = 0u;
    __syncthreads();
    XcdBarrier bar = xcd_barrier_post((unsigned*)(a.ws + WS_CTL) + CW_BAR, MISC + 8);

    { ARGS
    {
    for (int r = gw; r < TA; r += NGW) {
        bf16_t* orow = hn + (size_t)r * D;
        if (r < T) rms_row_bf16(x + (size_t)r * D, g_mix, orow, lane);
        else if (r < T + NMETA) rms_row_bf16(meta + (size_t)(r - T) * D, g_mix, orow, lane);
        else { u32x2* o8 = (u32x2*)orow; for (int j = 0; j < 8; ++j) o8[lane + 64 * j] = (u32x2){0u, 0u}; }
    }
    for (int idx = vcu * NT + tid; idx < NE * D; idx += G * NT) {
        const int e = idx >> 11, k = idx & (D - 1);
        const float v = g_ffn[k] * rw[(size_t)k * NE + e]; const unsigned hi = f2bf(v); const float res = v - bf2f(hi);
        wrT[idx] = (bf16_t)hi; wrT[NE * D + idx] = (bf16_t)f2bf(res);
    }
    { LAS float* scr = (LAS float*)(lds + wave * 16384);
      constexpr int I_IN = 32 * 272, I_AO = 16 * 64, I_OUT = P5_FP8 ? 16 * 64 : 32 * 64, I_AO8 = 8 * 64;
      constexpr int NITEMS = I_IN + (P4_ATT_FP8 ? I_AO8 : I_AO) + I_AO + I_OUT;
      for (int it = gw; it < NITEMS; it += NGW) {
          int r = it;
          if (r < I_IN) { p0_transpose_item(w_in, IN_DIM, winT, D, 0, scr, r / 272, r % 272, lane); continue; } r -= I_IN;
          if constexpr (P4_ATT_FP8) { if (r < I_AO8) { p0_convert_item_fp8(w_ao, D, (unsigned char*)wacT, AC_PITCH, r / 64, r % 64, lane); continue; } r -= I_AO8; }
          else { if (r < I_AO) { p0_transpose_item(w_ao, D, wacT, D, 0, scr, r / 64, r % 64, lane); continue; } r -= I_AO; }
          if (r < I_AO) { p0_transpose_item(w_co, D, wacT, AC_PITCH / 2, AC_CONV_OFF / 2, scr, r / 64, r % 64, lane); continue; } r -= I_AO;
          if constexpr (P5_FP8) p0_convert_item_fp8(w_out, D, (unsigned char*)woutT, D, r / 64, r % 64, lane);
          else p0_transpose_item(w_out, D, woutT, D, 0, scr, r / 64, r % 64, lane);
      } }
    }
    }
    xcd_barrier(bar);

    { ARGS
    {
        const int GG = (G >= 256 && (G & 7) == 0) ? CONV_GG : G;
        if (bxid < GG) { pg8::DenseOrder S; S.init(hn, winT, D, D, T, IN_DIM, GG, bxid, 14, 4);
          pg8::EpiProj E{proj};
          pg8::gemm_phase<pg8::EpiProj, pg8::DenseOrder, true>(lds, D * 2, D * 2, D * 2, S, E); }
        int nxt = 0; if (lane == 0) nxt = (int)atomicAdd(&ctl[CW_CQ], 1u);
        for (;;) {
            const int chunk = __builtin_amdgcn_readfirstlane(nxt);
            if (chunk >= MOE_CHUNKS) break;
            if (lane == 0) nxt = (int)atomicAdd(&ctl[CW_CQ], 1u);
            moe_convert_chunk(chunk, wgu, wd, wguT8, wdT8, lane);
        }
    }
    }
    xcd_barrier(bar);

    { ARGS
    for (int u = bxid; u < 256; u += G) {
        __syncthreads();
        attn_unit(lds, proj, sink, ac, u >> 7, (u >> 2) & 31, u & 3);
    }
    for (int idx = vcu * NT + tid; idx < T * (CDIM / 8); idx += G * NT) {
        const int r = idx >> 7, c = (idx & 127) * 8, s = r & (SEQ - 1);
        const bf16_t* p = proj + (size_t)r * IN_DIM + c;
        const bf16_t* pm = (s == 0) ? proj + (size_t)(T + NMETA - 1) * IN_DIM + c : p - IN_DIM;
        const u32x4 c1 = *(const u32x4*)(p + OFF_CC), h1v = *(const u32x4*)(p + OFF_CH), c0 = *(const u32x4*)(pm + OFF_CC), h0v = *(const u32x4*)(pm + OFF_CH), cb = *(const u32x4*)(p + OFF_CB);
        u32x4 c2 = (u32x4){0u, 0u, 0u, 0u}, h2v = (u32x4){0u, 0u, 0u, 0u};
        if (s != SEQ - 1) { c2 = *(const u32x4*)(p + IN_DIM + OFF_CC); h2v = *(const u32x4*)(p + IN_DIM + OFF_CH); }
        const f32x4 w0a = *(const f32x4*)(conv_w + c), w0b = *(const f32x4*)(conv_w + c + 4), w1a = *(const f32x4*)(conv_w + CDIM + c), w1b = *(const f32x4*)(conv_w + CDIM + c + 4),
                    w2a = *(const f32x4*)(conv_w + 2 * CDIM + c), w2b = *(const f32x4*)(conv_w + 2 * CDIM + c + 4);
        float o[8];
#pragma unroll
        for (int q = 0; q < 4; ++q) {
            const unsigned a0 = c0[q], b0 = h0v[q], a1 = c1[q], b1 = h1v[q], a2 = c2[q], b2 = h2v[q], gb = cb[q];
            const float wl0 = (q < 2) ? w0a[2 * q] : w0b[2 * q - 4], wh0 = (q < 2) ? w0a[2 * q + 1] : w0b[2 * q - 3];
            const float wl1 = (q < 2) ? w1a[2 * q] : w1b[2 * q - 4], wh1 = (q < 2) ? w1a[2 * q + 1] : w1b[2 * q - 3];
            const float wl2 = (q < 2) ? w2a[2 * q] : w2b[2 * q - 4], wh2 = (q < 2) ? w2a[2 * q + 1] : w2b[2 * q - 3];
            o[2 * q] = bflo(gb) * (bflo(a0) * bflo(b0) * wl0 + bflo(a1) * bflo(b1) * wl1 + bflo(a2) * bflo(b2) * wl2);
            o[2 * q + 1] = bfhi(gb) * (bfhi(a0) * bfhi(b0) * wh0 + bfhi(a1) * bfhi(b1) * wh1 + bfhi(a2) * bfhi(b2) * wh2);
        }
        u32x4 w; w.x = pk2(o[0], o[1]); w.y = pk2(o[2], o[3]); w.z = pk2(o[4], o[5]); w.w = pk2(o[6], o[7]);
        *(u32x4*)((unsigned char*)ac + (size_t)r * AC_PITCH + AC_CONV_OFF + c * 2) = w;
    }
    }
    xcd_barrier(bar);

    { ARGS
    { pg8::DenseOrder S; S.init(ac, wacT, AC_PITCH / 2, AC_PITCH / 2, T, D, G, bxid); pg8::EpiGated E{proj, merged};
      pg8::gemm_phase<pg8::EpiGated, pg8::DenseOrder, false, false, false, true, P4_ATT_FP8 ? 8 : 0>(lds, AC_PITCH, AC_PITCH, AC_PITCH, S, E); }
    }
    xcd_barrier(bar);

    { ARGS
    if constexpr (P5_FP8) { pg8::DenseOrder S; S.init(merged, woutT, D / 2, D / 2, T, D, G, bxid); pg8::EpiH1 E{x, h1, 1.0f / (WSCALE * MSCALE)};
      pg8::gemm_phase<pg8::EpiH1, pg8::DenseOrder, false, true>(lds, D, D, D, S, E); }
    else { pg8::DenseOrder S; S.init(merged, woutT, D, D, T, D, G, bxid); pg8::EpiH1 E{x, h1, 1.0f};
      pg8::gemm_phase<pg8::EpiH1, pg8::DenseOrder, false>(lds, D * 2, D * 2, D * 2, S, E); }
    }
    xcd_barrier(bar);

    { ARGS
    {
        f32x4 gg[8];
#pragma unroll
        for (int j = 0; j < 8; ++j) gg[j] = ((const f32x4*)g_ffn)[lane + 64 * j];
        LAS float* pr = (LAS float*)lds;
        LAS float* tinf = (LAS float*)(lds + 32768);
        LAS unsigned* cntL = (LAS unsigned*)(lds + 36864); LAS unsigned* baseL = cntL + NE;
        const int r = lane & 15, q = lane >> 4;
        for (int blk = vcu; blk < T / 32; blk += G) {
            const int tb = blk * 32;
            {
                const int task = wave & 1, kq = wave >> 1, t0 = tb + 16 * task;
                const float* xrow = h1 + (size_t)(t0 + r) * D + 512 * kq + 8 * q;
                const bf16_t* wh = wrT + (size_t)r * D + 512 * kq + 8 * q; const bf16_t* wl = wh + NE * D;
                f32x4 acc0 = (f32x4){0.f, 0.f, 0.f, 0.f}, acc1 = (f32x4){0.f, 0.f, 0.f, 0.f}; float ssq = 0.f;
#pragma unroll 8
                for (int ks = 0; ks < 16; ++ks) {
                    const f32x4 x0 = *(const f32x4*)(xrow + 32 * ks), x1 = *(const f32x4*)(xrow + 32 * ks + 4);
                    ssq += (x0.x * x0.x + x0.y * x0.y) + (x0.z * x0.z + x0.w * x0.w) + (x1.x * x1.x + x1.y * x1.y) + (x1.z * x1.z + x1.w * x1.w);
                    unsigned hb[8]; float rs8[8];
#pragma unroll
                    for (int i = 0; i < 4; ++i) { hb[i] = f2bf(x0[i]); rs8[i] = x0[i] - bf2f(hb[i]); hb[4 + i] = f2bf(x1[i]); rs8[4 + i] = x1[i] - bf2f(hb[4 + i]); }
                    u32x4 ahw, alw;
                    ahw.x = hb[0] | (hb[1] << 16); ahw.y = hb[2] | (hb[3] << 16); ahw.z = hb[4] | (hb[5] << 16); ahw.w = hb[6] | (hb[7] << 16);
                    alw.x = pk2(rs8[0], rs8[1]); alw.y = pk2(rs8[2], rs8[3]); alw.z = pk2(rs8[4], rs8[5]); alw.w = pk2(rs8[6], rs8[7]);
                    const bf16x8 ah = __builtin_bit_cast(bf16x8, ahw), al = __builtin_bit_cast(bf16x8, alw);
                    const bf16x8 bh0 = *(const bf16x8*)(wh + 32 * ks), bh1 = *(const bf16x8*)(wh + 16 * D + 32 * ks), bl0 = *(const bf16x8*)(wl + 32 * ks), bl1 = *(const bf16x8*)(wl + 16 * D + 32 * ks);
                    acc0 = __builtin_amdgcn_mfma_f32_16x16x32_bf16(ah, bh0, acc0, 0, 0, 0); acc0 = __builtin_amdgcn_mfma_f32_16x16x32_bf16(ah, bl0, acc0, 0, 0, 0); acc0 = __builtin_amdgcn_mfma_f32_16x16x32_bf16(al, bh0, acc0, 0, 0, 0);
                    acc1 = __builtin_amdgcn_mfma_f32_16x16x32_bf16(ah, bh1, acc1, 0, 0, 0); acc1 = __builtin_amdgcn_mfma_f32_16x16x32_bf16(ah, bl1, acc1, 0, 0, 0); acc1 = __builtin_amdgcn_mfma_f32_16x16x32_bf16(al, bh1, acc1, 0, 0, 0);
                }
                LAS float* p = pr + (wave * 64 + lane) * 9;
                p[0] = acc0[0]; p[1] = acc0[1]; p[2] = acc0[2]; p[3] = acc0[3]; p[4] = acc1[0]; p[5] = acc1[1]; p[6] = acc1[2]; p[7] = acc1[3]; p[8] = ssq;
                if (wave == 2 && lane < NE) cntL[lane] = 0u;
            }
            __syncthreads();
            int mye = 0, lrank = 0; float myg = 0.f, rstd_r = 0.f;
            if (wave < 2) {
                const int t0 = tb + 16 * wave;
                f32x4 acc0 = (f32x4){0.f, 0.f, 0.f, 0.f}, acc1 = (f32x4){0.f, 0.f, 0.f, 0.f}; float ssq = 0.f;
#pragma unroll
                for (int k4 = 0; k4 < 4; ++k4) { const LAS float* p = pr + ((k4 * 2 + wave) * 64 + lane) * 9;
                    acc0[0] += p[0]; acc0[1] += p[1]; acc0[2] += p[2]; acc0[3] += p[3]; acc1[0] += p[4]; acc1[1] += p[5]; acc1[2] += p[6]; acc1[3] += p[7]; ssq += p[8]; }
                ssq += __shfl_xor(ssq, 16); ssq += __shfl_xor(ssq, 32);
                rstd_r = 1.0f / sqrtf(ssq * (1.0f / D) + RMS_EPS);
                const float b0 = rb[r], b1 = rb[r + 16];
                const int jj = r >> 2, kk = r & 3;
#pragma unroll
                for (int j = 0; j < 4; ++j) {
                    const float rs = __shfl(rstd_r, 4 * q + j);
                    float v0 = acc0[j] * rs + b0, v1 = acc1[j] * rs + b1;
                    float sv[4]; int se[4];
#pragma unroll
                    for (int k = 0; k < 4; ++k) {
                        float bv = v0; int be = r; if (v1 > v0) { bv = v1; be = r + 16; }
#pragma unroll
                        for (int o = 1; o < 16; o <<= 1) { const float ov = __shfl_xor(bv, o); const int oe = __shfl_xor(be, o); if (ov > bv || (ov == bv && oe < be)) { bv = ov; be = oe; } }
                        sv[k] = bv; se[k] = be; if (be == r) v0 = -3.0e38f; if (be == r + 16) v1 = -3.0e38f;
                    }
                    const float e1 = __expf(sv[1] - sv[0]), e2 = __expf(sv[2] - sv[0]), e3 = __expf(sv[3] - sv[0]), inv = 1.0f / (1.0f + e1 + e2 + e3);
                    const int se_k = (kk == 0) ? se[0] : (kk == 1) ? se[1] : (kk == 2) ? se[2] : se[3];
                    const float g_k = ((kk == 0) ? 1.0f : (kk == 1) ? e1 : (kk == 2) ? e2 : e3) * inv;
                    if (jj == j) { mye = se_k; myg = g_k; }
                }
                lrank = (int)__hip_atomic_fetch_add(cntL + mye, 1u, __ATOMIC_RELAXED, __HIP_MEMORY_SCOPE_WORKGROUP);
            }
            __syncthreads();
            if (wave == 0 && lane < NE) { const unsigned c = cntL[lane]; baseL[lane] = c ? atomicAdd(&ctl[CW_CNT + 64 * lane], c) : 0u; }
            __syncthreads();
            if (wave < 2) {
                const int t0 = tb + 16 * wave, kk = lane & 3;
                const int slot = mye * ECAP + (int)baseL[mye] + lrank;
                gatel[slot] = myg; pos[(t0 + (lane >> 2)) * 4 + kk] = slot;
                if (lane < 16) tinf[(16 * wave + lane) * 8] = rstd_r;
                ((LAS int*)tinf)[(16 * wave + (lane >> 2)) * 8 + 1 + kk] = slot;
            }
            __syncthreads();
#pragma unroll
            for (int i = 0; i < 4; ++i) {
                const int tt = 4 * wave + i;
                const float rs = tinf[tt * 8];
                const int s0 = ((const LAS int*)tinf)[tt * 8 + 1], s1 = ((const LAS int*)tinf)[tt * 8 + 2], s2 = ((const LAS int*)tinf)[tt * 8 + 3], s3 = ((const LAS int*)tinf)[tt * 8 + 4];
                const f32x4* xr = (const f32x4*)(h1 + (size_t)(tb + tt) * D);
                unsigned* o0 = (unsigned*)(xs8 + (size_t)s0 * D); unsigned* o1 = (unsigned*)(xs8 + (size_t)s1 * D); unsigned* o2 = (unsigned*)(xs8 + (size_t)s2 * D); unsigned* o3 = (unsigned*)(xs8 + (size_t)s3 * D);
#pragma unroll
                for (int j = 0; j < 8; ++j) { const f32x4 v = xr[lane + 64 * j]; const unsigned w = pg8::pk4_fp8(v.x * rs * gg[j].x, v.y * rs * gg[j].y, v.z * rs * gg[j].z, v.w * rs * gg[j].w);
                    o0[lane + 64 * j] = w; o1[lane + 64 * j] = w; o2[lane + 64 * j] = w; o3[lane + 64 * j] = w; }
            }
            if (blk + G < T / 32) __syncthreads();
        }
    }
    }
    xcd_barrier(bar);

    { ARGS
    { pg8::MoeOrder S; S.init(xs8, wguT8, ctl, DFF / 128, (size_t)2 * DFF * D, DFF, G, bxid); pg8::EpiAct E{bgu, act8};
      pg8::gemm_phase<pg8::EpiAct, pg8::MoeOrder, true, true>(lds, D, D, D, S, E); }
    }
    xcd_barrier(bar);

    { ARGS
    { pg8::MoeOrder S; S.init(act8, wdT8, ctl, D / 256, (size_t)D * DFF, 0, G, bxid); pg8::EpiY E{bd, gatel, yr};
      pg8::gemm_phase<pg8::EpiY, pg8::MoeOrder, true, true>(lds, DFF, DFF, DFF, S, E); }
    }
    xcd_barrier(bar);

    { ARGS
    for (int t = gw; t < T; t += NGW) {
        const f32x4* xr = (const f32x4*)(h1 + (size_t)t * D); const f32x4* gr = (const f32x4*)g_fin;
        f32x4 v[8];
#pragma unroll
        for (int j = 0; j < 8; ++j) v[j] = xr[lane + 64 * j];
#pragma unroll
        for (int k = 0; k < 4; ++k) {
            const int* y4 = (const int*)(yr + (size_t)pos[t * 4 + k] * D);
#pragma unroll
            for (int j = 0; j < 8; ++j) { const int w = y4[lane + 64 * j]; const f32x2 lo = __builtin_amdgcn_cvt_pk_f32_fp8(w, false), hi = __builtin_amdgcn_cvt_pk_f32_fp8(w, true);
                v[j].x += lo.x * YSCALE_INV; v[j].y += lo.y * YSCALE_INV; v[j].z += hi.x * YSCALE_INV; v[j].w += hi.y * YSCALE_INV; }
        }
        float s = 0.f;
#pragma unroll
        for (int j = 0; j < 8; ++j) s += (v[j].x * v[j].x + v[j].y * v[j].y) + (v[j].z * v[j].z + v[j].w * v[j].w);
        s = wave_sum(s);
        const float rstd = 1.0f / sqrtf(s * (1.0f / D) + RMS_EPS);
        f32x4* orow = (f32x4*)(out + (size_t)t * D);
#pragma unroll
        for (int j = 0; j < 8; ++j) { const f32x4 gg = gr[lane + 64 * j]; f32x4 y; y.x = v[j].x * rstd * gg.x; y.y = v[j].y * rstd * gg.y; y.z = v[j].z * rstd * gg.z; y.w = v[j].w * rstd * gg.w; orow[lane + 64 * j] = y; }
    }

    }
}
}

extern "C" void kernel_launch(void* const* d_in, const int* in_sizes, int n_in, void* d_out, int out_size, void* d_ws, size_t ws_size, hipStream_t stream) {
    static int grid = 0;
    if (grid == 0) {
        if (n_in != 17 || out_size != T * D || ws_size < WS_END) { fprintf(stderr, "kernel_launch: unexpected shapes (n_in %d out %d ws %zu, need %zu)\n", n_in, out_size, ws_size, (size_t)WS_END); grid = -1; return; }
        int dev = 0, cus = 0, per_cu = 0;
        if (hipGetDevice(&dev) != hipSuccess || hipDeviceGetAttribute(&cus, hipDeviceAttributeMultiprocessorCount, dev) != hipSuccess) { grid = -1; return; }
        if (hipFuncSetAttribute((const void*)fwd, hipFuncAttributeMaxDynamicSharedMemorySize, LDS_BYTES) != hipSuccess) { fprintf(stderr, "kernel_launch: hipFuncSetAttribute failed\n"); grid = -1; return; }
        if (hipOccupancyMaxActiveBlocksPerMultiprocessor(&per_cu, (const void*)fwd, NT, LDS_BYTES) != hipSuccess || per_cu < 1) { fprintf(stderr, "kernel_launch: occupancy query says %d blocks per CU\n", per_cu); grid = -1; return; }
        (void)hipGetLastError();
        grid = cus;
    }
    if (grid < 0) return;
    if (hipMemsetAsync((char*)d_ws + WS_CTL, 0, CTL_BYTES, stream) != hipSuccess) return;
    Args a{};
    for (int i = 0; i < 17; ++i) a.in[i] = (const float*)d_in[i];
    a.out = (float*)d_out; a.ws = (unsigned char*)d_ws;
    hipLaunchKernelGGL(fwd, dim3(grid), dim3(NT), LDS_BYTES, stream, a);
}
```
